# Optimizing an MI355X kernel written in HIP

```python
import math, functools
import jax, jax.numpy as jnp
from jax import lax
import numpy as np

D_MODEL = 1024
BATCH = 16
SEQ = 2048
DEPTH = 1

D_MIX = D_MODEL
ATTN_WIDTH = D_MIX // 2
ATTN_HEADS = 8
ATTN_HEAD_DIM = ATTN_WIDTH // ATTN_HEADS
MLSTM_WIDTH = D_MIX - ATTN_WIDTH
MLSTM_HEADS = 4
MLSTM_HEAD_DIM = MLSTM_WIDTH // MLSTM_HEADS
DILATED_CONFIGS = ((128, 1), (512, 4), (2048, 16))
ATTN_BLOCK = 128
MLSTM_CHUNK = 64
CONV_WIDTH = 4
D_FF = ((8 * D_MODEL // 3) + 127) // 128 * 128
NORM_EPS = 1e-6
D_IN = 3 * ATTN_WIDTH + 4 * MLSTM_WIDTH + 2 * MLSTM_HEADS
SPLIT_POINTS = (ATTN_WIDTH, 2 * ATTN_WIDTH, 3 * ATTN_WIDTH,
                3 * ATTN_WIDTH + MLSTM_WIDTH, 3 * ATTN_WIDTH + 2 * MLSTM_WIDTH,
                3 * ATTN_WIDTH + 3 * MLSTM_WIDTH, 3 * ATTN_WIDTH + 4 * MLSTM_WIDTH,
                3 * ATTN_WIDTH + 4 * MLSTM_WIDTH + MLSTM_HEADS)

kernel_name = "hybrid_dilated_attn_mlstm_macaron"


def rmsnorm(x, w):
    xf = x.astype(jnp.float32)
    y = xf * lax.rsqrt(jnp.mean(xf * xf, axis=-1, keepdims=True) + NORM_EPS)
    return (y * w.astype(jnp.float32)).astype(x.dtype)


def swiglu(x, w_gate, w_up, w_down):
    return (jax.nn.silu(x @ w_gate) * (x @ w_up)) @ w_down


def alibi_slopes(n_heads):
    h = np.arange(1, n_heads + 1, dtype=np.float32)
    return jnp.asarray(2.0 ** (-8.0 * h / n_heads), dtype=jnp.float32)


def split_heads(t, n_heads):
    B, S, _ = t.shape
    return t.reshape(B, S, n_heads, -1).transpose(0, 2, 1, 3)


def merge_heads(t):
    B, H, S, dh = t.shape
    return t.transpose(0, 2, 1, 3).reshape(B, S, H * dh)


def dilated_branch(q, k, v, slopes, window, dilation):
    B, H, S, hd = q.shape
    blk = ATTN_BLOCK
    n_steps = window // dilation
    assert n_steps <= blk
    L = S // dilation
    nb = -(-L // blk)
    Lp = nb * blk

    def residues(t):
        return t.reshape(B, H, L, dilation, hd).transpose(0, 1, 3, 2, 4)

    qb = jnp.pad(residues(q), ((0, 0), (0, 0), (0, 0), (0, Lp - L), (0, 0)))
    qb = qb.reshape(B, H, dilation, nb, blk, hd)

    def key_blocks(t):
        tp = jnp.pad(residues(t), ((0, 0), (0, 0), (0, 0), (blk, Lp - L), (0, 0)))
        tp = tp.reshape(B, H, dilation, nb + 1, blk, hd)
        return jnp.concatenate([tp[:, :, :, :-1], tp[:, :, :, 1:]], axis=4)

    kb, vb = key_blocks(k), key_blocks(v)
    steps = np.arange(blk)[:, None] + blk - np.arange(2 * blk)[None, :]
    band = (steps >= 0) & (steps <= n_steps)
    exists = (np.arange(nb)[:, None, None] > 0) | (np.arange(2 * blk)[None, None, :] >= blk)
    mask = jnp.asarray(band[None] & exists)
    dist = jnp.asarray((steps * dilation).astype(np.float32))
    s = jnp.einsum('bhrnqd,bhrnkd->bhrnqk', qb, kb)
    s = s - slopes.reshape(H, 1, 1, 1, 1) * dist
    s = jnp.where(mask, s, -jnp.inf)
    m = jnp.max(s, axis=-1, keepdims=True)
    p = jnp.exp(s - m)
    denom = jnp.sum(p, axis=-1, keepdims=True)
    o = jnp.einsum('bhrnqk,bhrnkd->bhrnqd', p, vb) / denom
    lse = (m + jnp.log(denom))[..., 0]
    o = o.reshape(B, H, dilation, Lp, hd)[:, :, :, :L].transpose(0, 1, 3, 2, 4).reshape(B, H, S, hd)
    lse = lse.reshape(B, H, dilation, Lp)[:, :, :, :L].transpose(0, 1, 3, 2).reshape(B, H, S)
    return o, lse


def dilated_attention(q, k, v):
    slopes = alibi_slopes(q.shape[1])
    outs, lses = [], []
    for window, dilation in DILATED_CONFIGS:
        o, lse = dilated_branch(q, k, v, slopes, window, dilation)
        outs.append(o)
        lses.append(lse)
    w = jax.nn.softmax(jnp.stack(lses, axis=0), axis=0)
    return jnp.einsum('gbhs,gbhsd->bhsd', w, jnp.stack(outs, axis=0))


def causal_dwconv(x, w, b):
    K = w.shape[0]
    S = x.shape[1]
    xp = jnp.pad(x, ((0, 0), (K - 1, 0), (0, 0)))
    y = b
    for j in range(K):
        y = y + xp[:, j:j + S] * w[j]
    return y


def mlstm_chunkwise(q, k, v, i_pre, f_pre):
    B, H, S, dh = q.shape
    L = MLSTM_CHUNK
    nc = S // L
    logf = jax.nn.log_sigmoid(f_pre)

    def chunks(t):
        t = t.reshape((B, H, nc, L) + t.shape[3:])
        return jnp.moveaxis(t, 2, 0)

    causal = jnp.asarray(np.tril(np.ones((L, L), dtype=bool)))

    def step(carry, inp):
        C, n, m = carry
        qc, kc, vc, ic, lfc = inp
        b = jnp.cumsum(lfc, axis=-1)
        D = b[..., :, None] - b[..., None, :] + ic[..., None, :]
        D = jnp.where(causal, D, -jnp.inf)
        g = b + m[..., None]
        m_row = jnp.maximum(g, jnp.max(D, axis=-1))
        Dw = jnp.exp(D - m_row[..., None])
        gw = jnp.exp(g - m_row)
        sc = jnp.einsum('bhtd,bhsd->bhts', qc, kc) * Dw
        num = gw[..., None] * jnp.einsum('bhtd,bhde->bhte', qc, C) + jnp.einsum('bhts,bhse->bhte', sc, vc)
        den = gw * jnp.einsum('bhtd,bhd->bht', qc, n) + jnp.sum(sc, axis=-1)
        h = num / jnp.maximum(jnp.abs(den), jnp.exp(-m_row))[..., None]
        bL = b[..., -1]
        a = bL[..., None] - b + ic
        m_new = jnp.maximum(bL + m, jnp.max(a, axis=-1))
        decay = jnp.exp(bL + m - m_new)
        w = jnp.exp(a - m_new[..., None])
        C_new = decay[..., None, None] * C + jnp.einsum('bhs,bhsd,bhse->bhde', w, kc, vc)
        n_new = decay[..., None] * n + jnp.einsum('bhs,bhsd->bhd', w, kc)
        return (C_new, n_new, m_new), h

    init = (jnp.zeros((B, H, dh, dh), jnp.float32), jnp.zeros((B, H, dh), jnp.float32),
            jnp.zeros((B, H), jnp.float32))
    _, hs = lax.scan(step, init, (chunks(q), chunks(k), chunks(v), chunks(i_pre), chunks(logf)))
    return jnp.moveaxis(hs, 0, 2).reshape(B, H, S, dh)


def head_rmsnorm(t, w):
    return t * lax.rsqrt(jnp.mean(t * t, axis=-1, keepdims=True) + NORM_EPS) * w


def hybrid_mixer(h, w_in, q_norm_w, k_norm_w, conv_w, conv_b, i_bias, f_bias,
                 attn_out_gain, mlstm_out_gain, w_out):
    dtype = h.dtype
    proj = (h @ w_in).astype(jnp.float32)
    qa, ka, va, qm, km, vm, om, ig, fg = jnp.split(proj, SPLIT_POINTS, axis=-1)

    scale = ATTN_HEAD_DIM ** -0.5
    qa = head_rmsnorm(split_heads(qa, ATTN_HEADS), q_norm_w.astype(jnp.float32)) * scale
    ka = head_rmsnorm(split_heads(ka, ATTN_HEADS), k_norm_w.astype(jnp.float32))
    va = split_heads(va, ATTN_HEADS)
    attn = dilated_attention(qa, ka, va)
    attn = head_rmsnorm(attn, attn_out_gain.astype(jnp.float32).reshape(ATTN_HEADS, 1, ATTN_HEAD_DIM))

    qk = jax.nn.silu(causal_dwconv(jnp.concatenate([qm, km], axis=-1),
                                   conv_w.astype(jnp.float32), conv_b.astype(jnp.float32)))
    qm, km = jnp.split(qk, 2, axis=-1)
    qm = split_heads(qm, MLSTM_HEADS)
    km = split_heads(km, MLSTM_HEADS) * (MLSTM_HEAD_DIM ** -0.5)
    vm = split_heads(vm, MLSTM_HEADS)
    i_pre = (ig + i_bias.astype(jnp.float32)).transpose(0, 2, 1)
    f_pre = (fg + f_bias.astype(jnp.float32)).transpose(0, 2, 1)
    hm = mlstm_chunkwise(qm, km, vm, i_pre, f_pre)
    hm = jax.nn.sigmoid(split_heads(om, MLSTM_HEADS)) * hm
    hm = head_rmsnorm(hm, mlstm_out_gain.astype(jnp.float32).reshape(MLSTM_HEADS, 1, MLSTM_HEAD_DIM))

    y = jnp.concatenate([merge_heads(attn), merge_heads(hm)], axis=-1).astype(dtype)
    return y @ w_out


def setup_inputs(seed: int = 0) -> dict:
    key = jax.random.key(seed)
    ks = jax.random.split(key, 24)
    f32 = jnp.float32

    def normal(k, shape, scale):
        return jax.random.normal(k, shape, f32) * scale

    def gain(k, shape):
        return 1.0 + 0.05 * jax.random.normal(k, shape, f32)

    f_bias = (jnp.linspace(3.0, 6.0, MLSTM_HEADS, dtype=f32)[None, :]
              + 0.1 * jax.random.normal(ks[12], (DEPTH, MLSTM_HEADS), f32))
    return {
        "x": jax.random.normal(ks[0], (BATCH, SEQ, D_MODEL), f32),
        "ffn1_norm_w": gain(ks[1], (DEPTH, D_MODEL)),
        "ffn1_w_gate": normal(ks[2], (DEPTH, D_MODEL, D_FF), D_MODEL ** -0.5),
        "ffn1_w_up": normal(ks[3], (DEPTH, D_MODEL, D_FF), D_MODEL ** -0.5),
        "ffn1_w_down": normal(ks[4], (DEPTH, D_FF, D_MODEL), D_FF ** -0.5),
        "mix_norm_w": gain(ks[5], (DEPTH, D_MODEL)),
        "w_in": normal(ks[6], (DEPTH, D_MODEL, D_IN), D_MODEL ** -0.5),
        "q_norm_w": gain(ks[7], (DEPTH, ATTN_HEAD_DIM)),
        "k_norm_w": gain(ks[8], (DEPTH, ATTN_HEAD_DIM)),
        "conv_w": normal(ks[9], (DEPTH, CONV_WIDTH, 2 * MLSTM_WIDTH), CONV_WIDTH ** -0.5),
        "conv_b": normal(ks[10], (DEPTH, 2 * MLSTM_WIDTH), 0.02),
        "i_bias": normal(ks[11], (DEPTH, MLSTM_HEADS), 0.1),
        "f_bias": f_bias,
        "attn_out_gain": gain(ks[13], (DEPTH, ATTN_WIDTH)),
        "mlstm_out_gain": gain(ks[14], (DEPTH, MLSTM_WIDTH)),
        "w_out": normal(ks[15], (DEPTH, D_MIX, D_MODEL), D_MIX ** -0.5),
        "ffn2_norm_w": gain(ks[16], (DEPTH, D_MODEL)),
        "ffn2_w_gate": normal(ks[17], (DEPTH, D_MODEL, D_FF), D_MODEL ** -0.5),
        "ffn2_w_up": normal(ks[18], (DEPTH, D_MODEL, D_FF), D_MODEL ** -0.5),
        "ffn2_w_down": normal(ks[19], (DEPTH, D_FF, D_MODEL), D_FF ** -0.5),
    }


def reference(x, ffn1_norm_w, ffn1_w_gate, ffn1_w_up, ffn1_w_down, mix_norm_w, w_in,
              q_norm_w, k_norm_w, conv_w, conv_b, i_bias, f_bias, attn_out_gain,
              mlstm_out_gain, w_out, ffn2_norm_w, ffn2_w_gate, ffn2_w_up, ffn2_w_down):
    for l in range(DEPTH):
        x = x + 0.5 * swiglu(rmsnorm(x, ffn1_norm_w[l]), ffn1_w_gate[l], ffn1_w_up[l], ffn1_w_down[l])
        x = x + hybrid_mixer(rmsnorm(x, mix_norm_w[l]), w_in[l], q_norm_w[l], k_norm_w[l],
                             conv_w[l], conv_b[l], i_bias[l], f_bias[l], attn_out_gain[l],
                             mlstm_out_gain[l], w_out[l])
        x = x + 0.5 * swiglu(rmsnorm(x, ffn2_norm_w[l]), ffn2_w_gate[l], ffn2_w_up[l], ffn2_w_down[l])
    return x
```

```cpp
#include <hip/hip_runtime.h>
#include <hip/hip_cooperative_groups.h>
#include <cstdio>
#include <cstdint>
namespace cg = cooperative_groups;
#ifndef USE_NAIVE_ATTN
#define USE_NAIVE_ATTN 0
#endif
#ifndef USE_NAIVE_MLSTM
#define USE_NAIVE_MLSTM 0
#endif
#ifndef PROBE_DUP
#define PROBE_DUP 0
#endif
#ifndef REP0
#define REP0 1
#endif
#ifndef REP1
#define REP1 1
#endif
#ifndef REP3
#define REP3 1
#endif
#ifndef REP4A
#define REP4A 1
#endif
#ifndef REP4B
#define REP4B 1
#endif
#ifndef REP4C
#define REP4C 1
#endif
namespace pg8 {
#define PG8_LAS __attribute__((address_space(3)))
typedef unsigned short bf16_t;
typedef short bf16x8 __attribute__((ext_vector_type(8)));
typedef float f32x4 __attribute__((ext_vector_type(4)));
typedef unsigned u32x4 __attribute__((ext_vector_type(4)));
constexpr int BM = 256, BK = 64, HALF = 128, HTB = HALF * BK * 2  , STAGE_BYTES = 8 * HTB, NXCD = 8, WGM = 8;

__host__ __device__ __forceinline__ int lds_byte(int r, int c) { const int st = (r >> 4) * 2 + (c >> 5), rr = r & 15, cc = c & 31, ob = rr * 64 + cc * 2; return st * 1024 + (ob ^ (((ob >> 9) & 1) << 5)); }
__host__ __device__ __forceinline__ void stage_rc(int b, int& R, int& C) { const int st = b / 1024, sb = b % 1024, swz = sb ^ (((sb >> 9) & 1) << 5); R = (st >> 1) * 16 + swz / 64; C = (st & 1) * 32 + (swz % 64) / 2; }
__host__ __device__ __forceinline__ int perm32(int rho) { const int n = rho >> 4, i = rho & 15; return 8 * (i >> 2) + 4 * n + (i & 3); }

struct Unit { int pm, pn; };
struct Gemm { const bf16_t* A; const bf16_t* Bt; int M, N, K; };

struct StaticOrder {
    int nM, nN, nwg, G, c;
    __host__ __device__ void init(int M, int N, int G_, int c_) { nM = M / BM; nN = N / BM; nwg = nM * nN; G = G_; c = c_; }
    __host__ __device__ bool next(int i, Unit& u) const {
        const long L = (long)i * G + c; if (L >= nwg) return false;
        int wgid = (int)L; { const int q = nwg / NXCD, r = nwg % NXCD, xcd = wgid % NXCD, off = wgid / NXCD; wgid = (xcd < r ? xcd * (q + 1) : r * (q + 1) + (xcd - r) * q) + off; }
        const int nig = WGM * nN, gid = wgid / nig, fm = gid * WGM, gsz = (nM - fm) < WGM ? (nM - fm) : WGM;
        u.pm = fm + ((wgid % nig) % gsz); u.pn = (wgid % nig) / gsz; return true;
    }
    __device__ __forceinline__ void a_ready(const Unit&) const {}
    __device__ __forceinline__ void done(const Unit&) const {}
};

__device__ __forceinline__ unsigned cvt_pk_bf16(float lo, float hi) { unsigned r; asm volatile("v_cvt_pk_bf16_f32 %0, %1, %2" : "=v"(r) : "v"(lo), "v"(hi)); return r; }
typedef float f32x2 __attribute__((ext_vector_type(2)));
template <class Epi, class Sched, bool ALIGN_EPI = false, bool SP2 = false>
__device__ __forceinline__ void gemm_phase(PG8_LAS unsigned char* lds, const Gemm g, const Sched& S, const Epi& E) {
    int tid = threadIdx.x; asm volatile("" : "+v"(tid));
    const int wid = __builtin_amdgcn_readfirstlane(tid >> 6), lane = tid & 63, wr = wid >> 2, wc = wid & 3, fr = lane & 15, fq = lane >> 4;
    const int K = g.K, nt = K / BK;
    unsigned voffA[2], voffB[2];
#pragma unroll
    for (int i = 0; i < 2; ++i) { int R, C; stage_rc(tid * 16 + i * 8192, R, C); const int Rb = Epi::PERM ? ((R & ~31) + perm32(R & 31)) : R;
        voffA[i] = (unsigned)(R * K + C) * 2u; voffB[i] = (unsigned)(Rb * K + C) * 2u; }
    const size_t kstep = (size_t)(BK * 2);
    const size_t hstep = (size_t)HALF * K * 2;
    const size_t tstep = 2 * hstep;
    const unsigned ldsw = (unsigned)wid * 1024u;
    const int aoff = lds_byte(wr * 64 + fr, fq * 8), boff = lds_byte(wc * 32 + fr, fq * 8);
#define PG8_SA(b, h) (((b) * 2 + (h)) * HTB)
#define PG8_SB(b, h) ((4 + (b) * 2 + (h)) * HTB)
#define PG8_STAGE(bufoff, gbase, voff) do { _Pragma("unroll") for (int _i = 0; _i < 2; ++_i) \
        __builtin_amdgcn_global_load_lds((const unsigned*)((const char*)(gbase) + (voff)[_i]), (PG8_LAS unsigned*)(lds + (bufoff) + ldsw + _i * 8192), 16, 0, 0); } while (0)
#define PG8_LDA(dst, b, h) do { _Pragma("unroll") for (int m = 0; m < 4; ++m) _Pragma("unroll") for (int k = 0; k < 2; ++k) dst[m][k] = *(const PG8_LAS bf16x8*)(lds + PG8_SA(b, h) + aoff + m * 2048 + k * 1024); } while (0)
#define PG8_LDB(dst, b, h) do { _Pragma("unroll") for (int n = 0; n < 2; ++n) _Pragma("unroll") for (int k = 0; k < 2; ++k) dst[n][k] = *(const PG8_LAS bf16x8*)(lds + PG8_SB(b, h) + boff + n * 2048 + k * 1024); } while (0)
#define PG8_MMA(ai, bj, At, Bt) do { __builtin_amdgcn_s_setprio(1); _Pragma("unroll") for (int m = 0; m < 4; ++m) _Pragma("unroll") for (int n = 0; n < 2; ++n) _Pragma("unroll") for (int k = 0; k < 2; ++k) \
        acc[ai][bj][m][n] = __builtin_amdgcn_mfma_f32_16x16x32_bf16(Bt[n][k], At[m][k], acc[ai][bj][m][n], 0, 0, 0); __builtin_amdgcn_s_setprio(0); } while (0)
#define PG8_WAIT_V(n) asm volatile("s_waitcnt vmcnt(" #n ")" ::: "memory")
#define PG8_WAIT_L(n) asm volatile("s_waitcnt lgkmcnt(" #n ")" ::: "memory")
#define PG8_BAR __builtin_amdgcn_s_barrier()
#define PG8_SCHED __builtin_amdgcn_sched_barrier(0)
    Unit cur, nxt; int ui = 0;
    if (!S.next(0, cur)) return;
    f32x4 acc[2][2][4][2];
#pragma unroll
    for (int a = 0; a < 2; ++a)
#pragma unroll
        for (int b = 0; b < 2; ++b)
#pragma unroll
            for (int m = 0; m < 4; ++m)
#pragma unroll
                for (int n = 0; n < 2; ++n) acc[a][b][m][n] = (f32x4){0.f, 0.f, 0.f, 0.f};
    bf16x8 At[4][2], B0[2][2], B1[2][2];
    const char* cA = (const char*)g.A + (size_t)cur.pm * tstep; const char* cB = (const char*)g.Bt + (size_t)cur.pn * tstep;
    S.a_ready(cur);
    if constexpr (SP2) {
        PG8_STAGE(PG8_SB(0, 0), cB, voffB); PG8_STAGE(PG8_SB(0, 1), cB + hstep, voffB); PG8_STAGE(PG8_SA(0, 0), cA, voffA); PG8_STAGE(PG8_SA(0, 1), cA + hstep, voffA);
        if (wr == 1) PG8_BAR;
        PG8_WAIT_V(2); PG8_BAR;
        PG8_STAGE(PG8_SB(1, 0), cB + kstep, voffB); PG8_STAGE(PG8_SA(1, 0), cA + kstep, voffA); PG8_STAGE(PG8_SB(1, 1), cB + hstep + kstep, voffB);
        PG8_WAIT_V(6); PG8_BAR;
    } else {
        PG8_STAGE(PG8_SB(0, 0), cB, voffB); PG8_STAGE(PG8_SA(0, 0), cA, voffA); PG8_STAGE(PG8_SB(0, 1), cB + hstep, voffB); PG8_STAGE(PG8_SA(0, 1), cA + hstep, voffA);
        if (wr == 1) PG8_BAR;
        PG8_WAIT_V(4); PG8_BAR;
        PG8_STAGE(PG8_SB(1, 0), cB + kstep, voffB); PG8_STAGE(PG8_SA(1, 0), cA + kstep, voffA); PG8_STAGE(PG8_SB(1, 1), cB + hstep + kstep, voffB);
        PG8_WAIT_V(6); PG8_BAR;
    }
    for (;;) {
        const bool has_next = S.next(ui + 1, nxt);
        const char* nA = has_next ? (const char*)g.A + (size_t)nxt.pm * tstep : cA; const char* nB = has_next ? (const char*)g.Bt + (size_t)nxt.pn * tstep : cB;
        for (int t = 0; t < nt; t += 2) {
            const bool last = (t == nt - 2);
            const char* a1 = cA + (size_t)(t + 1) * kstep;
            const char* a2 = last ? nA : cA + (size_t)(t + 2) * kstep; const char* b2 = last ? nB : cB + (size_t)(t + 2) * kstep;
            const char* a3 = a2 + kstep; const char* b3 = b2 + kstep;
            if (last && has_next) S.a_ready(nxt);
            if constexpr (SP2) {
            PG8_LDB(B0, 0, 0); PG8_LDB(B1, 0, 1); PG8_SCHED; PG8_LDA(At, 0, 0); PG8_STAGE(PG8_SA(1, 1), a1 + hstep, voffA);
            PG8_WAIT_V(8); PG8_WAIT_L(0); PG8_BAR; PG8_MMA(0, 0, At, B0); PG8_MMA(0, 1, At, B1); PG8_BAR; PG8_SCHED;
            PG8_LDA(At, 0, 1); PG8_STAGE(PG8_SB(0, 0), b2, voffB); PG8_STAGE(PG8_SB(0, 1), b2 + hstep, voffB); PG8_STAGE(PG8_SA(0, 0), a2, voffA);
            PG8_WAIT_V(8); PG8_WAIT_L(0); PG8_BAR; PG8_MMA(1, 0, At, B0); PG8_MMA(1, 1, At, B1); PG8_BAR; PG8_SCHED;
            PG8_LDB(B0, 1, 0); PG8_LDB(B1, 1, 1); PG8_SCHED; PG8_LDA(At, 1, 0); PG8_STAGE(PG8_SA(0, 1), a2 + hstep, voffA);
            PG8_WAIT_V(8); PG8_WAIT_L(0); PG8_BAR; PG8_MMA(0, 0, At, B0); PG8_MMA(0, 1, At, B1); PG8_BAR; PG8_SCHED;
            PG8_LDA(At, 1, 1); PG8_STAGE(PG8_SB(1, 0), b3, voffB); PG8_STAGE(PG8_SB(1, 1), b3 + hstep, voffB); PG8_STAGE(PG8_SA(1, 0), a3, voffA);
            PG8_WAIT_V(8); PG8_WAIT_L(0); PG8_BAR; PG8_MMA(1, 0, At, B0); PG8_MMA(1, 1, At, B1); PG8_BAR; PG8_SCHED;
            } else {
            PG8_LDB(B0, 0, 0); PG8_SCHED; PG8_LDA(At, 0, 0); PG8_STAGE(PG8_SA(1, 1), a1 + hstep, voffA);
            PG8_WAIT_L(8); PG8_BAR; PG8_WAIT_L(0); PG8_MMA(0, 0, At, B0); PG8_BAR; PG8_SCHED;
            PG8_LDB(B1, 0, 1); PG8_STAGE(PG8_SB(0, 0), b2, voffB);
            PG8_BAR; PG8_WAIT_L(0); PG8_MMA(0, 1, At, B1); PG8_BAR;
            PG8_LDA(At, 0, 1); PG8_STAGE(PG8_SA(0, 0), a2, voffA);
            PG8_BAR; PG8_WAIT_L(0); PG8_MMA(1, 0, At, B0); PG8_BAR; PG8_SCHED;
            PG8_STAGE(PG8_SB(0, 1), b2 + hstep, voffB);
            PG8_WAIT_V(6); PG8_BAR; PG8_MMA(1, 1, At, B1); PG8_BAR;
            PG8_LDB(B0, 1, 0); PG8_SCHED; PG8_LDA(At, 1, 0); PG8_STAGE(PG8_SA(0, 1), a2 + hstep, voffA);
            PG8_WAIT_L(8); PG8_BAR; PG8_WAIT_L(0); PG8_MMA(0, 0, At, B0); PG8_BAR; PG8_SCHED;
            PG8_LDB(B1, 1, 1); PG8_STAGE(PG8_SB(1, 0), b3, voffB);
            PG8_BAR; PG8_WAIT_L(0); PG8_MMA(0, 1, At, B1); PG8_BAR;
            PG8_LDA(At, 1, 1); PG8_STAGE(PG8_SA(1, 0), a3, voffA);
            PG8_BAR; PG8_WAIT_L(0); PG8_MMA(1, 0, At, B0); PG8_BAR; PG8_SCHED;
            PG8_STAGE(PG8_SB(1, 1), b3 + hstep, voffB);
            PG8_WAIT_V(6); PG8_BAR; PG8_MMA(1, 1, At, B1); PG8_BAR;
            }
        }
        if constexpr (ALIGN_EPI) { if (wr == 0) PG8_BAR; }
        if constexpr (!Epi::AFTER_DRAIN) { E(acc, cur, wr, wc, fr, fq); S.done(cur); }
        if (!has_next) break;
#pragma unroll
        for (int a = 0; a < 2; ++a)
#pragma unroll
            for (int b = 0; b < 2; ++b)
#pragma unroll
                for (int m = 0; m < 4; ++m)
#pragma unroll
                    for (int n = 0; n < 2; ++n) acc[a][b][m][n] = (f32x4){0.f, 0.f, 0.f, 0.f};
        cur = nxt; cA = nA; cB = nB; ++ui;
        if constexpr (ALIGN_EPI) { if (wr == 1) PG8_BAR; }
    }
    PG8_WAIT_V(0);
    if constexpr (!ALIGN_EPI) { if (wr == 0) PG8_BAR; }
    PG8_BAR;
    if constexpr (Epi::AFTER_DRAIN) { E.fused(acc, cur, wr, wc, fr, fq, lds, wid, lane); S.done(cur); }
#undef PG8_SA
#undef PG8_SB
#undef PG8_STAGE
#undef PG8_LDA
#undef PG8_LDB
#undef PG8_MMA
#undef PG8_WAIT_V
#undef PG8_WAIT_L
#undef PG8_BAR
#undef PG8_SCHED
}
}

#define LAS __attribute__((address_space(3)))
typedef pg8::bf16_t bf16_t;
typedef pg8::f32x4 f32x4;
typedef pg8::u32x4 u32x4;
typedef pg8::bf16x8 bf16x8;
typedef unsigned u32x2 __attribute__((ext_vector_type(2)));
constexpr int MTOK = 32768, SEQL = 2048, DM = 1024, DFF = 2816, NGU = 2 * DFF, DINP = 3840, DIN = 3592, PW = 3584;
constexpr float EPS = 1e-6f, LOG2E = 1.4426950408889634f;
constexpr size_t MiB = 1u << 20;
constexpr size_t WS_SS2 = 0, WS_SS3 = 128 * 1024, WS_BAR = 512 * 1024;
constexpr size_t WS_WG1 = 2 * MiB, WS_WD1 = 14 * MiB, WS_WG2 = 20 * MiB, WS_WD2 = 32 * MiB, WS_WIN = 38 * MiB, WS_WOUT = 46 * MiB;
constexpr size_t WS_XN = 48 * MiB, WS_H = 112 * MiB, WS_G = 336 * MiB, WS_P4 = 337 * MiB, WS_P16 = 369 * MiB, WS_L4 = 401 * MiB, WS_L16 = 402 * MiB;
constexpr size_t WS_QC = 403 * MiB, WS_KC = 435 * MiB, WS_XN3 = WS_QC, WS_DEN = 467 * MiB, WS_BC = 468 * MiB, WS_DSEG = 469 * MiB, WS_FIMG = 470 * MiB, WS_END = 492 * MiB;
constexpr int PC_QA = 0, PC_KA = 512, PC_VA = 1024, PC_QM = 1536, PC_KM = 2048, PC_VM = 2560, PC_OM = 3072;
constexpr int LDS_BYTES = 147456;

__device__ __forceinline__ int tid_here() { int t = threadIdx.x; asm volatile("" : "+v"(t)); return t; }
__device__ __forceinline__ float bf2f(unsigned short b) { return __uint_as_float((unsigned)b << 16); }
__device__ __forceinline__ unsigned pk2(float lo, float hi) { return pg8::cvt_pk_bf16(lo, hi); }
__device__ __forceinline__ unsigned short f2bf1(float f) { return (unsigned short)(pk2(f, 0.f) & 0xffffu); }
__device__ __forceinline__ float sigmoid_f(float x) { return __builtin_amdgcn_rcpf(1.f + __builtin_amdgcn_exp2f(-x * LOG2E)); }
__device__ __forceinline__ float silu_f(float x) { return x * sigmoid_f(x); }
__device__ __forceinline__ float wave_sum(float v) {
#pragma unroll
    for (int o = 1; o < 64; o <<= 1) v += __shfl_xor(v, o);
    return v;
}

template <int CTRL, int RMASK> __device__ __forceinline__ float dpp_mov0(float x) { return __int_as_float(__builtin_amdgcn_update_dpp(0, __float_as_int(x), CTRL, RMASK, 0xF, true)); }
__device__ __forceinline__ float wave_incl_scan(float x) {
    x += dpp_mov0<0x111, 0xF>(x); x += dpp_mov0<0x112, 0xF>(x); x += dpp_mov0<0x114, 0xF>(x); x += dpp_mov0<0x118, 0xF>(x);
    x += dpp_mov0<0x142, 0xA>(x);
    x += dpp_mov0<0x143, 0xC>(x);
    return x;
}
struct EpiSwiGLU {
    static constexpr bool PERM = true, AFTER_DRAIN = false;
    bf16_t* H; const float* sumsq;
    __device__ __forceinline__ void operator()(const f32x4 (&acc)[2][2][4][2], const pg8::Unit& u, int wr, int wc, int fr, int fq) const {
        const int row0 = u.pm * 256 + wr * 64 + fr, col = u.pn * 128 + wc * 32 + 8 * fq;
#pragma unroll
        for (int ai = 0; ai < 2; ++ai)
#pragma unroll
            for (int m = 0; m < 4; ++m) {
                const int row = row0 + ai * 128 + m * 16;
                const float rs = sumsq ? rsqrtf(sumsq[row] * (1.f / 1024.f) + EPS) : 1.f;
                float o[8];
#pragma unroll
                for (int n = 0; n < 2; ++n)
#pragma unroll
                    for (int e = 0; e < 4; ++e) { const float g = acc[ai][0][m][n][e] * rs, up = acc[ai][1][m][n][e] * rs; o[4 * n + e] = silu_f(g) * up; }
                u32x4 w; w.x = pk2(o[0], o[1]); w.y = pk2(o[2], o[3]); w.z = pk2(o[4], o[5]); w.w = pk2(o[6], o[7]);
                *(u32x4*)(H + (size_t)row * DFF + col) = w;
            }
    }
};
struct EpiResid {
    static constexpr bool PERM = false, AFTER_DRAIN = false;
    const float* base; float* out; float alpha; bf16_t* xw; const float* wn; float* sumsq;
    __device__ __forceinline__ void operator()(const f32x4 (&acc)[2][2][4][2], const pg8::Unit& u, int wr, int wc, int fr, int fq) const {
        const int row0 = u.pm * 256 + wr * 64 + fr, col0 = u.pn * 256 + wc * 32 + 4 * fq;
#pragma unroll
        for (int ai = 0; ai < 2; ++ai)
#pragma unroll
            for (int m = 0; m < 4; ++m) {
                const int row = row0 + ai * 128 + m * 16; float ss = 0.f;
#pragma unroll
                for (int bj = 0; bj < 2; ++bj)
#pragma unroll
                    for (int n = 0; n < 2; ++n) {
                        const size_t off = (size_t)row * DM + col0 + bj * 128 + n * 16;
                        const f32x4 b = *(const f32x4*)(base + off); const f32x4 o = b + acc[ai][bj][m][n] * alpha;
                        *(f32x4*)(out + off) = o;
                        if (xw) { ss += (o[0] * o[0] + o[1] * o[1]) + (o[2] * o[2] + o[3] * o[3]);
                            const f32x4 wv = *(const f32x4*)(wn + col0 + bj * 128 + n * 16);
                            u32x2 w; w.x = pk2(o[0] * wv[0], o[1] * wv[1]); w.y = pk2(o[2] * wv[2], o[3] * wv[3]); *(u32x2*)(xw + off) = w; }
                    }
                if (xw) { ss += __shfl_xor(ss, 16); ss += __shfl_xor(ss, 32); if (fq == 0) atomicAdd(sumsq + row, ss); }
            }
    }
};
template <bool BASE_BF16, bool OUT_BF16>
struct EpiResG {
    static constexpr bool PERM = true, AFTER_DRAIN = false;
    const void* base; void* out; float alpha; float* sumsq;
    __device__ __forceinline__ void operator()(const f32x4 (&acc)[2][2][4][2], const pg8::Unit& u, int wr, int wc, int fr, int fq) const {
        const int row0 = u.pm * 256 + wr * 64 + fr, col0 = u.pn * 256 + wc * 32 + 8 * fq;
#pragma unroll
        for (int ai = 0; ai < 2; ++ai)
#pragma unroll
            for (int m = 0; m < 4; ++m) {
                const int row = row0 + ai * 128 + m * 16; float ss = 0.f;
#pragma unroll
                for (int bj = 0; bj < 2; ++bj) {
                    const size_t off = (size_t)row * DM + col0 + bj * 128;
                    float o[8];
                    if (BASE_BF16) { const u32x4 bw = *(const u32x4*)((const bf16_t*)base + off);
#pragma unroll
                        for (int e = 0; e < 4; ++e) { o[2 * e] = __uint_as_float(bw[e] << 16); o[2 * e + 1] = __uint_as_float(bw[e] & 0xffff0000u); } }
                    else { const f32x4 b0 = *(const f32x4*)((const float*)base + off), b1 = *(const f32x4*)((const float*)base + off + 4);
#pragma unroll
                        for (int e = 0; e < 4; ++e) { o[e] = b0[e]; o[4 + e] = b1[e]; } }
#pragma unroll
                    for (int n = 0; n < 2; ++n)
#pragma unroll
                        for (int e = 0; e < 4; ++e) { const float v = o[4 * n + e] + alpha * acc[ai][bj][m][n][e]; o[4 * n + e] = v; ss += v * v; }
                    if (OUT_BF16) { u32x4 w; w.x = pk2(o[0], o[1]); w.y = pk2(o[2], o[3]); w.z = pk2(o[4], o[5]); w.w = pk2(o[6], o[7]); *(u32x4*)((bf16_t*)out + off) = w; }
                    else { *(f32x4*)((float*)out + off) = (f32x4){o[0], o[1], o[2], o[3]}; *(f32x4*)((float*)out + off + 4) = (f32x4){o[4], o[5], o[6], o[7]}; }
                }
                if (sumsq) { ss += __shfl_xor(ss, 16); ss += __shfl_xor(ss, 32); if (fq == 0) atomicAdd(sumsq + row, ss); }
            }
    }
};
struct EpiProj {
    static constexpr bool PERM = true, AFTER_DRAIN = false;
    bf16_t* P; float* G; const float* sumsq; const float* qw; const float* kw; const float* ib; const float* fb;
    __device__ __forceinline__ void operator()(const f32x4 (&acc)[2][2][4][2], const pg8::Unit& u, int wr, int wc, int fr, int fq) const {
        const int row0 = u.pm * 256 + wr * 64 + fr;
        if (u.pn < 4) {
            const float* w = (u.pn < 2) ? qw : kw; const float sc = (u.pn < 2) ? 0.125f * LOG2E : 1.f;
            f32x4 wv[2][2];
#pragma unroll
            for (int bj = 0; bj < 2; ++bj)
#pragma unroll
                for (int n = 0; n < 2; ++n) wv[bj][n] = *(const f32x4*)(w + 32 * bj + 8 * fq + 4 * n);
#pragma unroll
            for (int ai = 0; ai < 2; ++ai)
#pragma unroll
                for (int m = 0; m < 4; ++m) {
                    const int row = row0 + ai * 128 + m * 16;
                    const float rs = rsqrtf(sumsq[row] * (1.f / 1024.f) + EPS);
                    f32x4 v[2][2]; float ss = 0.f;
#pragma unroll
                    for (int bj = 0; bj < 2; ++bj)
#pragma unroll
                        for (int n = 0; n < 2; ++n) { v[bj][n] = acc[ai][bj][m][n] * rs; ss += (v[bj][n][0] * v[bj][n][0] + v[bj][n][1] * v[bj][n][1]) + (v[bj][n][2] * v[bj][n][2] + v[bj][n][3] * v[bj][n][3]); }
                    ss += __shfl_xor(ss, 16); ss += __shfl_xor(ss, 32);
                    const float r = rsqrtf(ss * (1.f / 64.f) + EPS) * sc;
#pragma unroll
                    for (int bj = 0; bj < 2; ++bj) {
                        const f32x4 a = v[bj][0] * wv[bj][0] * r, b = v[bj][1] * wv[bj][1] * r;
                        u32x4 o; o.x = pk2(a[0], a[1]); o.y = pk2(a[2], a[3]); o.z = pk2(b[0], b[1]); o.w = pk2(b[2], b[3]);
                        *(u32x4*)(P + (size_t)row * PW + u.pn * 256 + 64 * wc + 32 * bj + 8 * fq) = o;
                    }
                }
        } else if (u.pn < 14) {
#pragma unroll
            for (int ai = 0; ai < 2; ++ai)
#pragma unroll
                for (int m = 0; m < 4; ++m) {
                    const int row = row0 + ai * 128 + m * 16;
                    const float rs = rsqrtf(sumsq[row] * (1.f / 1024.f) + EPS);
#pragma unroll
                    for (int bj = 0; bj < 2; ++bj) {
                        const f32x4 a = acc[ai][bj][m][0] * rs, b = acc[ai][bj][m][1] * rs;
                        u32x4 o; o.x = pk2(a[0], a[1]); o.y = pk2(a[2], a[3]); o.z = pk2(b[0], b[1]); o.w = pk2(b[2], b[3]);
                        *(u32x4*)(P + (size_t)row * PW + u.pn * 256 + 128 * bj + 32 * wc + 8 * fq) = o;
                    }
                }
        } else {
            if (wc == 0 && fq == 0) {
                const f32x4 bi = *(const f32x4*)ib, bf = *(const f32x4*)fb;
#pragma unroll
                for (int ai = 0; ai < 2; ++ai)
#pragma unroll
                    for (int m = 0; m < 4; ++m) {
                        const int row = row0 + ai * 128 + m * 16;
                        const float rs = rsqrtf(sumsq[row] * (1.f / 1024.f) + EPS);
                        *(f32x4*)(G + (size_t)row * 8) = acc[ai][0][m][0] * rs + bi;
                        *(f32x4*)(G + (size_t)row * 8 + 4) = acc[ai][0][m][1] * rs + bf;
                    }
            }
        }
    }
};

__device__ __forceinline__ void gates_job(const bf16_t* XN, const bf16_t* WIN, const float* sumsq, const float* ib, const float* fb, float* G, LAS unsigned char* lds) {
    const int tid = tid_here(), lane = tid & 63, wave = tid >> 6, fr = lane & 15, fq = lane >> 4;
#pragma unroll
    for (int i = 0; i < 4; ++i) { const int pc = tid + 512 * i, rw = pc >> 7, ch = pc & 127;
        *(LAS u32x4*)(lds + rw * 2064 + 16 * ch) = *(const u32x4*)(WIN + (size_t)(3584 + rw) * 1024 + 8 * ch); }
    __syncthreads();
    for (int rb = blockIdx.x * 8 + wave; rb < MTOK / 16; rb += gridDim.x * 8) {
        const int row0 = rb * 16;
        const bf16_t* ap = XN + (size_t)(row0 + fr) * 1024 + 8 * fq;
        const LAS unsigned char* bp = lds + fr * 2064 + 16 * fq;
        bf16x8 af[32];
#pragma unroll
        for (int ks = 0; ks < 32; ++ks) af[ks] = *(const bf16x8*)(ap + 32 * ks);
        f32x4 acc = {0.f, 0.f, 0.f, 0.f};
#pragma unroll
        for (int ks = 0; ks < 32; ++ks) acc = __builtin_amdgcn_mfma_f32_16x16x32_bf16(af[ks], *(const LAS bf16x8*)(bp + 64 * ks), acc, 0, 0, 0);
        if (fr < 8) { const float bias = (fr < 4) ? ib[fr] : fb[fr - 4];
#pragma unroll
            for (int e = 0; e < 4; ++e) { const int row = row0 + 4 * fq + e; G[(size_t)row * 8 + fr] = acc[e] * rsqrtf(sumsq[row] * (1.f / 1024.f) + EPS) + bias; } }
    }
    __syncthreads();
}
__device__ __forceinline__ int dest_row0(int n0, int mode) {
    if (mode == 1) return 256 * (n0 / 128) + (n0 % 128);
    if (mode == 2) return 256 * (n0 / 128) + 128 + (n0 % 128);
    if (mode == 3 && n0 < 1024) { const int tile = n0 / 256, within = n0 % 256, wc = within / 64, bj = (within % 64) / 32; return 256 * tile + 128 * bj + 32 * wc; }
    return n0;
}
__device__ __forceinline__ void transpose_item(const float* W, int ldw, int nblk, int K, bf16_t* WT, int mode, LAS float* scr, int item, int lane, const float* kscale = nullptr) {
    const int kb = item / nblk, nb = item % nblk, k0 = 64 * kb, n0 = 32 * nb, d0 = dest_row0(n0, mode);
#pragma unroll 8
    for (int i = 0; i < 32; ++i) { const int kk = 2 * i + (lane >> 5); scr[kk * 33 + (lane & 31)] = W[(size_t)(k0 + kk) * ldw + n0 + (lane & 31)] * (kscale ? kscale[k0 + kk] : 1.f); }
    asm volatile("s_waitcnt lgkmcnt(0)" ::: "memory");
    const int c = lane & 7;
#pragma unroll
    for (int j = 0; j < 4; ++j) { const int n = (lane >> 3) + 8 * j; const LAS float* s = scr + (8 * c) * 33 + n;
        u32x4 o; o.x = pk2(s[0 * 33], s[1 * 33]); o.y = pk2(s[2 * 33], s[3 * 33]); o.z = pk2(s[4 * 33], s[5 * 33]); o.w = pk2(s[6 * 33], s[7 * 33]);
        *(u32x4*)(WT + (size_t)(d0 + n) * K + k0 + 8 * c) = o; }
    asm volatile("s_waitcnt lgkmcnt(0)" ::: "memory");
}
__device__ __forceinline__ void rms_row_to_bf16(const float* xrow, const float* w, bf16_t* orow, int lane) {
    const f32x4* xr = (const f32x4*)xrow + lane; const f32x4* wr_ = (const f32x4*)w + lane;
    f32x4 v[4]; float s = 0.f;
#pragma unroll
    for (int j = 0; j < 4; ++j) { v[j] = xr[64 * j]; s += (v[j][0] * v[j][0] + v[j][1] * v[j][1]) + (v[j][2] * v[j][2] + v[j][3] * v[j][3]); }
    const float rstd = rsqrtf(wave_sum(s) * (1.f / 1024.f) + EPS);
    u32x2* o8 = (u32x2*)orow + lane;
#pragma unroll
    for (int j = 0; j < 4; ++j) { const f32x4 g = wr_[64 * j]; u32x2 o; o.x = pk2(v[j][0] * rstd * g[0], v[j][1] * rstd * g[1]); o.y = pk2(v[j][2] * rstd * g[2], v[j][3] * rstd * g[3]); o8[64 * j] = o; }
}

struct Args { const float* in[20]; float* out; unsigned char* ws; };
enum { I_X = 0, I_N1, I_G1, I_U1, I_D1, I_NM, I_WIN, I_QNW, I_KNW, I_CW, I_CB, I_IB, I_FB, I_AG, I_MG, I_WO, I_N2, I_G2, I_U2, I_D2 };

__device__ __forceinline__ void prologue(const Args& a, LAS unsigned char* lds) {
    const int tid = tid_here(), lane = tid & 63, wave = tid >> 6, G = gridDim.x;
    const int gw = blockIdx.x * 8 + wave, NGW = G * 8; const int gt = blockIdx.x * 512 + tid, NGT = G * 512;
    unsigned char* ws = a.ws;
    for (int i = gt; i < 2 * MTOK; i += NGT) ((float*)(ws + WS_SS2))[i] = 0.f;
    { bf16_t* WIN = (bf16_t*)(ws + WS_WIN); const float* W = a.in[I_WIN];
      for (int i = gt; i < 8 * 1024; i += NGT) { const int j = i >> 10, k = i & 1023; WIN[(size_t)(3584 + j) * 1024 + k] = f2bf1(W[(size_t)k * DIN + 3584 + j] * a.in[I_NM][k]); }
      for (int i = gt; i < 248 * 1024 / 8; i += NGT) ((u32x4*)(WIN + (size_t)3592 * 1024))[i] = (u32x4){0u, 0u, 0u, 0u}; }
    LAS float* scr = (LAS float*)(lds + wave * 16384);
    constexpr int I_GU = 16 * 88, I_DN = 44 * 32, I_IN = 16 * 112, I_OUT = 16 * 32;
    constexpr int NITEMS = 4 * I_GU + 2 * I_DN + I_IN + I_OUT;
    const f32x4* wr_ = (const f32x4*)a.in[I_N1] + lane; f32x4 g[4];
#pragma unroll
    for (int j = 0; j < 4; ++j) g[j] = wr_[64 * j];
    for (int trip = 0; ; ++trip) {
        const int it = gw + trip * NGW, m = gw + 2 * trip * NGW, m2 = m + NGW;
        const bool has_it = it < NITEMS, has1 = m < MTOK, has2 = m2 < MTOK;
        if (!has_it && !has1) break;
        f32x4 va[4], vb[4];
        if (has1) { const f32x4* xa = (const f32x4*)(a.in[I_X] + (size_t)m * DM) + lane; const f32x4* xb = (const f32x4*)(a.in[I_X] + (size_t)(has2 ? m2 : m) * DM) + lane;
#pragma unroll
            for (int j = 0; j < 4; ++j) { va[j] = xa[64 * j]; vb[j] = xb[64 * j]; } }
        if (has_it) {
            int r = it;
            if (r < I_GU) transpose_item(a.in[I_G1], DFF, 88, 1024, (bf16_t*)(ws + WS_WG1), 1, scr, r, lane);
            else if ((r -= I_GU) < I_GU) transpose_item(a.in[I_U1], DFF, 88, 1024, (bf16_t*)(ws + WS_WG1), 2, scr, r, lane);
            else if ((r -= I_GU) < I_GU) transpose_item(a.in[I_G2], DFF, 88, 1024, (bf16_t*)(ws + WS_WG2), 1, scr, r, lane, a.in[I_N2]);
            else if ((r -= I_GU) < I_GU) transpose_item(a.in[I_U2], DFF, 88, 1024, (bf16_t*)(ws + WS_WG2), 2, scr, r, lane, a.in[I_N2]);
            else if ((r -= I_GU) < I_DN) transpose_item(a.in[I_D1], DM, 32, DFF, (bf16_t*)(ws + WS_WD1), 0, scr, r, lane);
            else if ((r -= I_DN) < I_DN) transpose_item(a.in[I_D2], DM, 32, DFF, (bf16_t*)(ws + WS_WD2), 0, scr, r, lane);
            else if ((r -= I_DN) < I_IN) transpose_item(a.in[I_WIN], DIN, 112, 1024, (bf16_t*)(ws + WS_WIN), 3, scr, r, lane, a.in[I_NM]);
            else { r -= I_IN; transpose_item(a.in[I_WO], DM, 32, 1024, (bf16_t*)(ws + WS_WOUT), 0, scr, r, lane); }
        }
        if (has1) {
            float sa = 0.f, sb = 0.f;
#pragma unroll
            for (int j = 0; j < 4; ++j) { sa += (va[j][0] * va[j][0] + va[j][1] * va[j][1]) + (va[j][2] * va[j][2] + va[j][3] * va[j][3]); sb += (vb[j][0] * vb[j][0] + vb[j][1] * vb[j][1]) + (vb[j][2] * vb[j][2] + vb[j][3] * vb[j][3]); }
            const float ra = rsqrtf(wave_sum(sa) * (1.f / 1024.f) + EPS), rb = rsqrtf(wave_sum(sb) * (1.f / 1024.f) + EPS);
            u32x2* oa = (u32x2*)((bf16_t*)(ws + WS_XN) + (size_t)m * DM) + lane; u32x2* ob = (u32x2*)((bf16_t*)(ws + WS_XN) + (size_t)m2 * DM) + lane;
#pragma unroll
            for (int j = 0; j < 4; ++j) { u32x2 o; o.x = pk2(va[j][0] * ra * g[j][0], va[j][1] * ra * g[j][1]); o.y = pk2(va[j][2] * ra * g[j][2], va[j][3] * ra * g[j][3]); oa[64 * j] = o; }
            if (has2) {
#pragma unroll
                for (int j = 0; j < 4; ++j) { u32x2 o; o.x = pk2(vb[j][0] * rb * g[j][0], vb[j][1] * rb * g[j][1]); o.y = pk2(vb[j][2] * rb * g[j][2], vb[j][3] * rb * g[j][3]); ob[64 * j] = o; } }
        }
    }
}

__device__ __forceinline__ void attn_naive(const bf16_t* P, const float* gain, bf16_t* Y) {
    for (int idx = blockIdx.x * 512 + threadIdx.x; idx < 8 * MTOK; idx += gridDim.x * 512) {
        const int h = idx >> 15, row = idx & (MTOK - 1), t = row & (SEQL - 1);
        float q[64], o[64]; float l = 0.f;
        { const bf16_t* qp = P + (size_t)row * PW + PC_QA + h * 64;
#pragma unroll
          for (int c = 0; c < 8; ++c) { const u32x4 w = *(const u32x4*)(qp + 8 * c);
#pragma unroll
            for (int e = 0; e < 4; ++e) { q[8 * c + 2 * e] = __uint_as_float(w[e] << 16); q[8 * c + 2 * e + 1] = __uint_as_float(w[e] & 0xffff0000u); } } }
#pragma unroll
        for (int d = 0; d < 64; ++d) o[d] = 0.f;
        const float slope = exp2f(-(float)(h + 1)) * LOG2E;
        for (int g = 0; g < 3; ++g) {
            const int dil = (g == 0) ? 1 : (g == 1) ? 4 : 16;
            for (int j = 0; j <= 128; ++j) {
                const int dist = j * dil; if (dist > t) break;
                const bf16_t* kp = P + (size_t)(row - dist) * PW + PC_KA + h * 64; const bf16_t* vp = kp + (PC_VA - PC_KA);
                float s = 0.f;
#pragma unroll
                for (int c = 0; c < 8; ++c) { const u32x4 w = *(const u32x4*)(kp + 8 * c);
#pragma unroll
                    for (int e = 0; e < 4; ++e) { s += q[8 * c + 2 * e] * __uint_as_float(w[e] << 16); s += q[8 * c + 2 * e + 1] * __uint_as_float(w[e] & 0xffff0000u); } }
                const float p = exp2f(s - slope * (float)dist); l += p;
#pragma unroll
                for (int c = 0; c < 8; ++c) { const u32x4 w = *(const u32x4*)(vp + 8 * c);
#pragma unroll
                    for (int e = 0; e < 4; ++e) { o[8 * c + 2 * e] += p * __uint_as_float(w[e] << 16); o[8 * c + 2 * e + 1] += p * __uint_as_float(w[e] & 0xffff0000u); } }
            }
        }
        const float inv = 1.f / l; float ss = 0.f;
#pragma unroll
        for (int d = 0; d < 64; ++d) { o[d] *= inv; ss += o[d] * o[d]; }
        const float r = rsqrtf(ss * (1.f / 64.f) + EPS);
        bf16_t* yp = Y + (size_t)row * DM + h * 64; const float* gp = gain + h * 64;
#pragma unroll
        for (int c = 0; c < 8; ++c) { u32x4 w;
#pragma unroll
            for (int e = 0; e < 4; ++e) w[e] = pk2(o[8 * c + 2 * e] * r * gp[8 * c + 2 * e], o[8 * c + 2 * e + 1] * r * gp[8 * c + 2 * e + 1]);
            *(u32x4*)(yp + 8 * c) = w; }
    }
}
__device__ __forceinline__ void mlstm_naive(const bf16_t* P, const float* Gt, const float* cw, const float* cb, const float* gain, bf16_t* Y, LAS float* sm) {
    LAS float* qs = sm; LAS float* ks = sm + 128; LAS float* part = sm + 256; LAS float* red = sm + 768;
    const int tid = threadIdx.x, lane = tid & 63, e = tid & 127, g = tid >> 7;
    for (int st = blockIdx.x; st < 64; st += gridDim.x) {
        const int b = st >> 2, h = st & 3;
        float C[32]; float nn = 0.f;
#pragma unroll
        for (int d = 0; d < 32; ++d) C[d] = 0.f;
        for (int t = 0; t < SEQL; ++t) {
            const int row = b * SEQL + t;
            if (tid < 256) {
                const int which = tid >> 7, ch = h * 128 + (tid & 127), c = which * 512 + ch;
                float acc = cb[c];
#pragma unroll
                for (int j = 0; j < 4; ++j) { const int tt = t - 3 + j; if (tt >= 0) acc += cw[j * 1024 + c] * bf2f(P[(size_t)(row - 3 + j) * PW + PC_QM + which * 512 + ch]); }
                float val = silu_f(acc); if (which) val *= 0.08838834764831845f;
                (which ? ks : qs)[tid & 127] = val;
            }
            __syncthreads();
            const float ig = __expf(Gt[(size_t)row * 8 + h]), fg = sigmoid_f(Gt[(size_t)row * 8 + 4 + h]);
            const float ve = bf2f(P[(size_t)row * PW + PC_VM + h * 128 + e]);
            float pn = 0.f;
#pragma unroll
            for (int d = 0; d < 32; ++d) { const int dk = g * 32 + d; C[d] = fg * C[d] + ig * ks[dk] * ve; pn += qs[dk] * C[d]; }
            part[g * 128 + e] = pn;
            if (tid < 128) { nn = fg * nn + ig * ks[tid]; const float qn = wave_sum(qs[tid] * nn); if (lane == 0) red[tid >> 6] = qn; }
            __syncthreads();
            float hval = 0.f;
            if (tid < 128) {
                const float num = (part[e] + part[128 + e]) + (part[256 + e] + part[384 + e]);
                const float den = red[0] + red[1];
                hval = num / fmaxf(fabsf(den), 1.f);
                hval *= sigmoid_f(bf2f(P[(size_t)row * PW + PC_OM + h * 128 + e]));
                const float ss = wave_sum(hval * hval); if (lane == 0) red[2 + (tid >> 6)] = ss;
            }
            __syncthreads();
            if (tid < 128) { const float r = rsqrtf((red[2] + red[3]) * (1.f / 128.f) + EPS); Y[(size_t)row * DM + 512 + h * 128 + e] = f2bf1(hval * r * gain[h * 128 + e]); }
        }
    }
}
#define XB_TMO      128
#define XB_XCNT(j)  (256  + 64 * (j))
#define XB_XSUB(j)  (1280 + 64 * (j))
#define XB_XGEN(j)  (2304 + 64 * (j))
#define XB_TOP      3328
#define XB_TOPGEN   3392
#define XCD_BAR_WORDS 3456
#define XB_SPIN_CAP (1u << 18)

__device__ __forceinline__ unsigned xb_ld(unsigned* p)              { return __hip_atomic_load(p, __ATOMIC_RELAXED, __HIP_MEMORY_SCOPE_AGENT); }
__device__ __forceinline__ unsigned xb_add(unsigned* p, unsigned v) { return __hip_atomic_fetch_add(p, v, __ATOMIC_RELAXED, __HIP_MEMORY_SCOPE_AGENT); }
__device__ __forceinline__ unsigned xb_xcc_id() { return (unsigned)__builtin_amdgcn_s_getreg((3 << 11) | 20) & 0xFu; }
#define XB_SPIN(cond, bar) do { unsigned _sp = 0; while (cond) { __builtin_amdgcn_s_sleep(1); \
    if ((++_sp & 255u) == 0u) { if (xb_ld(&(bar)[XB_TMO])) break; if (_sp > XB_SPIN_CAP) { atomicAdd(&(bar)[XB_TMO], 1u); break; } } } } while (0)

struct XcdBarrier {
    unsigned* bar; unsigned x;
    volatile LAS unsigned* st;
};

__device__ __forceinline__ XcdBarrier xcd_barrier_post(unsigned* bar, volatile LAS unsigned* st) {
    XcdBarrier b; b.bar = bar; b.x = xb_xcc_id(); b.st = st;
    if (threadIdx.x == 0) (void)xb_add(&bar[XB_XCNT(b.x)], 1u);
    return b;
}
__device__ __forceinline__ void xcd_barrier_complete(unsigned* bar, unsigned x, unsigned& nloc, unsigned& nx) {
    const unsigned G = gridDim.x * gridDim.y * gridDim.z;
    unsigned sum, cnt, mine, sp = 0u;
    for (;;) {
        sum = 0u; cnt = 0u; mine = 0u;
#pragma unroll
        for (unsigned j = 0; j < 16; ++j) { const unsigned c = xb_ld(&bar[XB_XCNT(j)]); sum += c; cnt += (c > 0u) ? 1u : 0u; mine = (j == x) ? c : mine; }
        if (sum == G) break;
        __builtin_amdgcn_s_sleep(1);
        if ((++sp & 255u) == 0u) { if (xb_ld(&bar[XB_TMO])) break; if (sp > XB_SPIN_CAP) { atomicAdd(&bar[XB_TMO], 1u); break; } }
    }
    nloc = mine > 0u ? mine : 1u; nx = cnt > 0u ? cnt : 1u;
}

__device__ __forceinline__ void xcd_barrier(const XcdBarrier& b) {
    asm volatile("s_waitcnt vmcnt(0)" ::: "memory");
    __syncthreads();
    if (threadIdx.x == 0) {
        unsigned* bar = b.bar;
        __builtin_amdgcn_s_waitcnt(0);
        unsigned nloc = b.st[0], nx = b.st[1];
        if (nloc == 0u) { xcd_barrier_complete(bar, b.x, nloc, nx); b.st[0] = nloc; b.st[1] = nx; }
        const unsigned old = xb_add(&bar[XB_XSUB(b.x)], 1u);
        const unsigned gen = old / nloc;
        if (old + 1u == (gen + 1u) * nloc) {
            __builtin_amdgcn_fence(__ATOMIC_RELEASE, "agent");
            asm volatile("s_waitcnt vmcnt(0)" ::: "memory");
            const unsigned og = xb_add(&bar[XB_TOP], 1u);
            const unsigned tg = og / nx;
            if (og + 1u == (tg + 1u) * nx) xb_add(&bar[XB_TOPGEN], 1u);
            else XB_SPIN(xb_ld(&bar[XB_TOPGEN]) == tg, bar);
            __builtin_amdgcn_fence(__ATOMIC_ACQUIRE, "agent");
            xb_add(&bar[XB_XGEN(b.x)], 1u);
            asm volatile("s_waitcnt vmcnt(0)" ::: "memory");
        } else {
            XB_SPIN(xb_ld(&bar[XB_XGEN(b.x)]) == gen, bar);
            __builtin_amdgcn_fence(__ATOMIC_ACQUIRE, "agent");
            asm volatile("s_waitcnt vmcnt(0)" ::: "memory");
        }
    }
    __syncthreads();
}

typedef float f32x16 __attribute__((ext_vector_type(16)));
typedef short v4i16_t __attribute__((ext_vector_type(4)));
#define MFMA32(a, b, c) __builtin_amdgcn_mfma_f32_32x32x16_bf16((a), (b), (c), 0, 0, 0)
__device__ __forceinline__ int crow(int i, int h) { return (i & 3) + 8 * (i >> 2) + 4 * h; }
__device__ __forceinline__ bf16x8 tr2(const LAS unsigned char* p0, const LAS unsigned char* p1) {
    const v4i16_t lo = __builtin_amdgcn_ds_read_tr16_b64_v4i16((LAS v4i16_t*)p0), hi = __builtin_amdgcn_ds_read_tr16_b64_v4i16((LAS v4i16_t*)p1);
    return (bf16x8){lo[0], lo[1], lo[2], lo[3], hi[0], hi[1], hi[2], hi[3]};
}
__device__ __forceinline__ bf16x8 ld2x8(const bf16_t* p0, const bf16_t* p1) {
    const u32x2 a = *(const u32x2*)p0, b = *(const u32x2*)p1; const u32x4 w = {a.x, a.y, b.x, b.y}; return __builtin_bit_cast(bf16x8, w);
}
__device__ __forceinline__ bf16x8 lds2x8(const LAS unsigned char* p0, const LAS unsigned char* p1) {
    const u32x2 a = *(const LAS u32x2*)p0, b = *(const LAS u32x2*)p1; const u32x4 w = {a.x, a.y, b.x, b.y}; return __builtin_bit_cast(bf16x8, w);
}
#define PACK8(v, base) __builtin_bit_cast(bf16x8, (u32x4){pk2((v)[(base)], (v)[(base) + 1]), pk2((v)[(base) + 2], (v)[(base) + 3]), pk2((v)[(base) + 4], (v)[(base) + 5]), pk2((v)[(base) + 6], (v)[(base) + 7])})
#define LFENCE() asm volatile("" ::: "memory")

constexpr int VROW = 144;
template <int MODE>
__device__ __forceinline__ void attn_task(const bf16_t* PR, int b, int head, int res, int dil, int qt, LAS unsigned char* vl, bf16_t* Po, float* Lo,
                                          const bf16_t* P4, const bf16_t* P16, const float* L4, const float* L16, const float* gain, bf16_t* Y, int lane) {
    const int r = lane & 31, h = lane >> 5, li = lane & 15, gg = (lane >> 4) & 1;
    const size_t seqrow0 = (size_t)b * SEQL + res;
    const int q0 = 32 * qt;
    const size_t rstride = (size_t)dil * PW;
    bf16x8 qf[4];
    { const bf16_t* qp = PR + (seqrow0 + (size_t)(q0 + r) * dil) * PW + PC_QA + head * 64 + 8 * h;
#pragma unroll
      for (int s = 0; s < 4; ++s) qf[s] = *(const bf16x8*)(qp + 16 * s); }
    f32x16 o[2];
#pragma unroll
    for (int dt = 0; dt < 2; ++dt)
#pragma unroll
        for (int i = 0; i < 16; ++i) o[dt][i] = 0.f;
    float l = 0.f;
    const float slope = exp2f(-(float)(head + 1)) * LOG2E * (float)dil;
    const LAS unsigned char* trb = vl + (4 * h + (li >> 2)) * VROW + (16 * gg + 4 * (li & 3)) * 2;
    const int first = (q0 >= 128) ? 0 : ((128 - q0) >> 5);
    const size_t prow = (seqrow0 + (size_t)(q0 - 128 + 32 * first + (lane >> 3)) * dil) * PW + head * 64 + 8 * (lane & 7);
    const bf16_t* kp = PR + prow + PC_KA; const bf16_t* vp = PR + prow + PC_VA;
    LAS unsigned char* kl = vl + 4608;
    const int stoff = (lane >> 3) * VROW + 16 * (lane & 7);
    u32x4 kn[4], vn[4];
#pragma unroll
    for (int i = 0; i < 4; ++i) { kn[i] = *(const u32x4*)(kp + (size_t)(8 * i) * rstride); vn[i] = *(const u32x4*)(vp + (size_t)(8 * i) * rstride); }
    const int rr = r - 4 * h;
#pragma unroll 1
    for (int kt = first; kt < 5; ++kt) {
#pragma unroll
        for (int i = 0; i < 4; ++i) { *(LAS u32x4*)(kl + stoff + 8 * i * VROW) = kn[i]; *(LAS u32x4*)(vl + stoff + 8 * i * VROW) = vn[i]; }
        LFENCE();
        if (kt < 4) {
            kp += 32 * rstride; vp += 32 * rstride;
#pragma unroll
            for (int i = 0; i < 4; ++i) { kn[i] = *(const u32x4*)(kp + (size_t)(8 * i) * rstride); vn[i] = *(const u32x4*)(vp + (size_t)(8 * i) * rstride); }
        }
        const float fb = slope * (float)(rr + 128 - 32 * kt);
        f32x16 s;
#pragma unroll
        for (int i = 0; i < 16; ++i) s[i] = slope * (float)((i & 3) + 8 * (i >> 2)) - fb;
#pragma unroll
        for (int ks = 0; ks < 4; ++ks) s = MFMA32(*(const LAS bf16x8*)(kl + r * VROW + 32 * ks + 16 * h), qf[ks], s);
        if (kt == 0 || kt == 4) {
#pragma unroll
            for (int i = 0; i < 16; ++i) { const int c = (i & 3) + 8 * (i >> 2); const bool ok = (kt == 4) ? (c <= rr) : (c >= rr); s[i] = ok ? s[i] : -__builtin_inff(); }
        }
        float ls = 0.f;
#pragma unroll
        for (int i = 0; i < 16; ++i) { const float p = __builtin_amdgcn_exp2f(s[i]); s[i] = p; ls += p; }
        l += ls;
        const bf16x8 pf0 = PACK8(s, 0), pf1 = PACK8(s, 8);
#pragma unroll
        for (int dt = 0; dt < 2; ++dt) { const bf16x8 v0 = tr2(trb + 64 * dt, trb + 8 * VROW + 64 * dt), v1 = tr2(trb + 16 * VROW + 64 * dt, trb + 24 * VROW + 64 * dt);
            o[dt] = MFMA32(v0, pf0, o[dt]); o[dt] = MFMA32(v1, pf1, o[dt]); }
        LFENCE();
    }
    {
        const float lt0 = l + __shfl_xor(l, 32);
        const size_t row = seqrow0 + (size_t)(q0 + r) * dil;
        if (MODE == 0) {
#pragma unroll
            for (int dt = 0; dt < 2; ++dt)
#pragma unroll
                for (int ii = 0; ii < 4; ++ii) { u32x2 w; w.x = pk2(o[dt][4 * ii], o[dt][4 * ii + 1]); w.y = pk2(o[dt][4 * ii + 2], o[dt][4 * ii + 3]);
                    *(u32x2*)(Po + row * 512 + head * 64 + 32 * dt + 8 * ii + 4 * h) = w; }
            if (h == 0) Lo[row * 8 + head] = lt0;
        } else {
            const float lt = lt0 + L4[row * 8 + head] + L16[row * 8 + head]; const float inv = 1.f / lt; float ss = 0.f;
#pragma unroll
            for (int dt = 0; dt < 2; ++dt)
#pragma unroll
                for (int ii = 0; ii < 4; ++ii) { const size_t off = row * 512 + head * 64 + 32 * dt + 8 * ii + 4 * h;
                    const u32x2 a = *(const u32x2*)(P4 + off), c = *(const u32x2*)(P16 + off);
                    const float add[4] = {__uint_as_float(a.x << 16) + __uint_as_float(c.x << 16), __uint_as_float(a.x & 0xffff0000u) + __uint_as_float(c.x & 0xffff0000u),
                                          __uint_as_float(a.y << 16) + __uint_as_float(c.y << 16), __uint_as_float(a.y & 0xffff0000u) + __uint_as_float(c.y & 0xffff0000u)};
#pragma unroll
                    for (int e = 0; e < 4; ++e) { const float v = (o[dt][4 * ii + e] + add[e]) * inv; o[dt][4 * ii + e] = v; ss += v * v; } }
            ss += __shfl_xor(ss, 32);
            const float rr = rsqrtf(ss * (1.f / 64.f) + EPS);
#pragma unroll
            for (int dt = 0; dt < 2; ++dt)
#pragma unroll
                for (int ii = 0; ii < 4; ++ii) { const int d0 = head * 64 + 32 * dt + 8 * ii + 4 * h; const f32x4 gv = *(const f32x4*)(gain + d0);
                    u32x2 w; w.x = pk2(o[dt][4 * ii] * rr * gv[0], o[dt][4 * ii + 1] * rr * gv[1]); w.y = pk2(o[dt][4 * ii + 2] * rr * gv[2], o[dt][4 * ii + 3] * rr * gv[3]);
                    *(u32x2*)(Y + row * DM + d0) = w; }
        }
    }
}

__device__ __forceinline__ void conv_local(const bf16_t* PR, const float* cw, const float* cb, bf16_t* QC, bf16_t* KC, int st) {
    const int tid = tid_here(), oct = tid & 31, rrange = tid >> 5;
    const int b = st >> 4, hm = (st >> 2) & 3, seg = st & 3;
    const int c8 = (oct < 16) ? (hm * 128 + oct * 8) : (512 + hm * 128 + (oct - 16) * 8);
    float wgt[4][8], bias[8];
#pragma unroll
    for (int j = 0; j < 4; ++j) { const f32x4 w0 = *(const f32x4*)(cw + j * 1024 + c8), w1 = *(const f32x4*)(cw + j * 1024 + c8 + 4);
#pragma unroll
        for (int e = 0; e < 4; ++e) { wgt[j][e] = w0[e]; wgt[j][4 + e] = w1[e]; } }
    { const f32x4 b0 = *(const f32x4*)(cb + c8), b1 = *(const f32x4*)(cb + c8 + 4);
#pragma unroll
      for (int e = 0; e < 4; ++e) { bias[e] = b0[e]; bias[4 + e] = b1[e]; } }
    const float sc = (c8 >= 512) ? 0.08838834764831845f : 1.f;
    bf16_t* dst0 = (c8 >= 512) ? (KC + (c8 - 512)) : (QC + c8);
    {
        const int R0 = b * SEQL + seg * 512 + rrange * 32; const bool first = (R0 & (SEQL - 1)) == 0;
        float x1[8], x2[8], x3[8];
        { const bf16_t* src = PR + (size_t)R0 * PW + PC_QM + c8;
          u32x4 a1 = {0u, 0u, 0u, 0u}, a2 = a1, a3 = a1;
          if (!first) { a1 = *(const u32x4*)(src - PW); a2 = *(const u32x4*)(src - 2 * PW); a3 = *(const u32x4*)(src - 3 * PW); }
#pragma unroll
          for (int e = 0; e < 4; ++e) { x1[2 * e] = __uint_as_float(a1[e] << 16); x1[2 * e + 1] = __uint_as_float(a1[e] & 0xffff0000u);
              x2[2 * e] = __uint_as_float(a2[e] << 16); x2[2 * e + 1] = __uint_as_float(a2[e] & 0xffff0000u);
              x3[2 * e] = __uint_as_float(a3[e] << 16); x3[2 * e + 1] = __uint_as_float(a3[e] & 0xffff0000u); } }
#pragma unroll 4
        for (int i = 0; i < 32; ++i) {
            const u32x4 xv = *(const u32x4*)(PR + (size_t)(R0 + i) * PW + PC_QM + c8);
            float x0[8];
#pragma unroll
            for (int e = 0; e < 4; ++e) { x0[2 * e] = __uint_as_float(xv[e] << 16); x0[2 * e + 1] = __uint_as_float(xv[e] & 0xffff0000u); }
            u32x4 o;
#pragma unroll
            for (int e = 0; e < 4; ++e) {
                const float v0 = bias[2 * e] + wgt[0][2 * e] * x3[2 * e] + wgt[1][2 * e] * x2[2 * e] + wgt[2][2 * e] * x1[2 * e] + wgt[3][2 * e] * x0[2 * e];
                const float v1 = bias[2 * e + 1] + wgt[0][2 * e + 1] * x3[2 * e + 1] + wgt[1][2 * e + 1] * x2[2 * e + 1] + wgt[2][2 * e + 1] * x1[2 * e + 1] + wgt[3][2 * e + 1] * x0[2 * e + 1];
                o[e] = pk2(silu_f(v0) * sc, silu_f(v1) * sc); }
            *(u32x4*)(dst0 + (size_t)(R0 + i) * 512) = o;
#pragma unroll
            for (int e = 0; e < 8; ++e) { x3[e] = x2[e]; x2[e] = x1[e]; x1[e] = x0[e]; }
        }
    }
}

constexpr int KROW = 272, OROW = 80;
constexpr int ML_PARK = 65536, ML_QT = 106496;
constexpr int ML_KT = 0, ML_VT = 64 * KROW, ML_VW = 2 * 64 * KROW, ML_ONE_T = 3 * 64 * KROW, ML_ONE_W = ML_ONE_T + 64 * OROW, ML_TAB = ML_ONE_W + 64 * OROW;
__device__ __forceinline__ void ml_final1(f32x16 (&res)[2], const bf16_t* PR, size_t r0, int hm, int w, int r, int h, const LAS float* den_t, LAS float* ssq_t) {
#pragma unroll
    for (int tt = 0; tt < 2; ++tt) {
        const float dd = 1.f / fmaxf(fabsf(den_t[32 * tt + r]), 1.f); float ss = 0.f;
        const bf16_t* op = PR + (r0 + 32 * tt + r) * PW + PC_OM + hm * 128 + 32 * w + 4 * h;
#pragma unroll
        for (int g4 = 0; g4 < 4; ++g4) { const u32x2 ov = *(const u32x2*)(op + 8 * g4);
            const float og[4] = {__uint_as_float(ov.x << 16), __uint_as_float(ov.x & 0xffff0000u), __uint_as_float(ov.y << 16), __uint_as_float(ov.y & 0xffff0000u)};
#pragma unroll
            for (int e = 0; e < 4; ++e) { const float v = res[tt][4 * g4 + e] * dd * sigmoid_f(og[e]); res[tt][4 * g4 + e] = v; ss += v * v; } }
        ss += __shfl_xor(ss, 32);
        if (h == 0) ssq_t[64 * w + 32 * tt + r] = ss;
    }
}
__device__ __forceinline__ void ml_final2(const f32x16 (&res)[2], const float* gain, bf16_t* Y, size_t r0, int hm, int w, int r, int h, const LAS float* ssq_t) {
#pragma unroll
    for (int tt = 0; tt < 2; ++tt) {
        const int t = 32 * tt + r;
        const float rr = rsqrtf(((ssq_t[t] + ssq_t[64 + t]) + (ssq_t[128 + t] + ssq_t[192 + t])) * (1.f / 128.f) + EPS);
#pragma unroll
        for (int g4 = 0; g4 < 4; ++g4) { const int d0 = hm * 128 + 32 * w + 8 * g4 + 4 * h; const f32x4 gv = *(const f32x4*)(gain + d0);
            u32x2 o; o.x = pk2(res[tt][4 * g4] * rr * gv[0], res[tt][4 * g4 + 1] * rr * gv[1]); o.y = pk2(res[tt][4 * g4 + 2] * rr * gv[2], res[tt][4 * g4 + 3] * rr * gv[3]);
            *(u32x2*)(Y + (r0 + t) * DM + 512 + d0) = o; }
    }
}
__device__ __forceinline__ float* num_ptr(float* NB, size_t token, int hm) { return NB + token * 512 + hm * 128; }

__device__ __forceinline__ void mlstm_pass1(const bf16_t* PR, const bf16_t* QC, const bf16_t* KC, const float* Gt, const float* gain, bf16_t* Y, LAS unsigned char* lds,
                                            float* NB, float* DEN, float* BC, float* FIMG, float* DSEG, int st_first, int st_stride) {
    const int tid = tid_here(), lane = tid & 63, w = __builtin_amdgcn_readfirstlane(tid >> 6);
    const int r = lane & 31, h = lane >> 5, li = lane & 15, gg = (lane >> 4) & 1;
    LAS float* cs_t = (LAS float*)(lds + ML_TAB); LAS float* den_t = cs_t + 64; LAS float* ssq_t = cs_t + 128;
    for (int st = st_first; st < 256; st += st_stride) {
        const int b = st >> 4, hm = (st >> 2) & 3, seg = st & 3;
        __syncthreads();
        for (int i = tid; i < 64 * OROW / 4; i += 512) { ((LAS unsigned*)(lds + ML_ONE_T))[i] = ((i % (OROW / 4)) == 0) ? 0x00003f80u : 0u; ((LAS unsigned*)(lds + ML_ONE_W))[i] = 0u; }
        __syncthreads();
        f32x16 C[4];
#pragma unroll
        for (int i = 0; i < 4; ++i)
#pragma unroll
            for (int e = 0; e < 16; ++e) C[i][e] = 0.f;
        const LAS unsigned char* vtb = (w < 4) ? (lds + ML_VT + 64 * w) : (lds + ML_ONE_T);
        const LAS unsigned char* vwb = (w < 4) ? (lds + ML_VW + 64 * w) : (lds + ML_ONE_W);
        const int vstr = (w < 4) ? KROW : OROW;
        float Bseg = 0.f;
        const int frow = tid >> 4, fch = tid & 15;
        const size_t rs0 = (size_t)b * SEQL + 64 * (8 * seg);
        const bf16_t* pK = KC + (rs0 + frow) * 512 + hm * 128 + 8 * fch; const bf16_t* pQ = QC + (rs0 + frow) * 512 + hm * 128 + 8 * fch;
        const bf16_t* pV = PR + (rs0 + frow) * PW + PC_VM + hm * 128 + 8 * fch; const float* pG = Gt + (rs0 + lane) * 8 + hm;
        u32x4 fK[2], fV[2], fQ[2]; float f_ip, f_fp;
#pragma unroll
        for (int p = 0; p < 2; ++p) { fK[p] = *(const u32x4*)(pK + (size_t)32 * p * 512); fQ[p] = *(const u32x4*)(pQ + (size_t)32 * p * 512); fV[p] = *(const u32x4*)(pV + (size_t)32 * p * PW); }
        f_ip = pG[0]; f_fp = pG[4];
        for (int cc = 0; cc < 8; ++cc) {
            const size_t r0 = rs0 + 64 * cc;
            const float ip = f_ip, fp = f_fp;
            const float lf = -__logf(1.f + __expf(-fp));
            const float bsum = wave_incl_scan(lf);
            const float bL = __int_as_float(__builtin_amdgcn_readlane(__float_as_int(bsum), 63)), csv = ip - bsum, wgt = __expf(bL + csv), decay = __expf(bL);
#pragma unroll
            for (int p = 0; p < 2; ++p) { const int row = frow + 32 * p;
                const float wr_ = __shfl(wgt, row);
                u32x4 vw;
#pragma unroll
                for (int e = 0; e < 4; ++e) vw[e] = pk2(__uint_as_float(fV[p][e] << 16) * wr_, __uint_as_float(fV[p][e] & 0xffff0000u) * wr_);
                *(LAS u32x4*)(lds + ML_KT + row * KROW + 16 * fch) = fK[p]; *(LAS u32x4*)(lds + ML_VT + row * KROW + 16 * fch) = fV[p];
                *(LAS u32x4*)(lds + ML_VW + row * KROW + 16 * fch) = vw; *(LAS u32x4*)(lds + ML_QT + row * KROW + 16 * fch) = fQ[p]; }
            if (w == 0) { cs_t[lane] = csv; *(LAS unsigned short*)(lds + ML_ONE_W + lane * OROW) = f2bf1(wgt); }
            if (cc < 7) {
                pK += 64 * 512; pQ += 64 * 512; pV += (size_t)64 * PW; pG += 64 * 8;
#pragma unroll
                for (int p = 0; p < 2; ++p) { fK[p] = *(const u32x4*)(pK + (size_t)32 * p * 512); fQ[p] = *(const u32x4*)(pQ + (size_t)32 * p * 512); fV[p] = *(const u32x4*)(pV + (size_t)32 * p * PW); }
                f_ip = pG[0]; f_fp = pG[4];
            }
            __syncthreads();
            if (w < 5) {
#pragma unroll 1
                for (int tt = 0; tt < 2; ++tt) {
                    const LAS unsigned char* qb0 = lds + ML_QT + (32 * tt + r) * KROW + 8 * h;
                    f32x16 hi_, ha, S0, S1;
#pragma unroll
                    for (int e = 0; e < 16; ++e) { hi_[e] = 0.f; ha[e] = 0.f; S0[e] = 0.f; S1[e] = 0.f; }
                    const LAS unsigned char* kb0 = lds + ML_KT + r * KROW + 8 * h;
#pragma unroll
                    for (int i = 0; i < 4; ++i)
#pragma unroll
                        for (int s = 0; s < 2; ++s) {
                            const bf16x8 q = lds2x8(qb0 + 64 * i + 32 * s, qb0 + 64 * i + 32 * s + 16);
                            hi_ = MFMA32(PACK8(C[i], 8 * s), q, hi_);
                            S0 = MFMA32(lds2x8(kb0 + 64 * i + 32 * s, kb0 + 64 * i + 32 * s + 16), q, S0);
                            S1 = MFMA32(lds2x8(kb0 + 32 * KROW + 64 * i + 32 * s, kb0 + 32 * KROW + 64 * i + 32 * s + 16), q, S1);
                            if (s == 1) LFENCE();
                        }
                    const float bt = __shfl(bsum, 32 * tt + r);
                    const LAS unsigned char* vb = vtb + (4 * h + (li >> 2)) * vstr + (16 * gg + 4 * (li & 3)) * 2;
                    {
#pragma unroll
                        for (int g4 = 0; g4 < 4; ++g4) { const f32x4 cv = *(const LAS f32x4*)(cs_t + 8 * g4 + 4 * h);
#pragma unroll
                            for (int e = 0; e < 4; ++e) { const int sl = 8 * g4 + 4 * h + e; const bool ok = (tt == 1) || (sl <= r);
                                S0[4 * g4 + e] = ok ? S0[4 * g4 + e] * __builtin_amdgcn_exp2f((bt + cv[e]) * LOG2E) : 0.f; } }
                        ha = MFMA32(tr2(vb, vb + 8 * vstr), PACK8(S0, 0), ha);
                        ha = MFMA32(tr2(vb + 16 * vstr, vb + 24 * vstr), PACK8(S0, 8), ha);
                    }
                    if (tt == 1) {
#pragma unroll
                        for (int g4 = 0; g4 < 4; ++g4) { const f32x4 cv = *(const LAS f32x4*)(cs_t + 32 + 8 * g4 + 4 * h);
#pragma unroll
                            for (int e = 0; e < 4; ++e) { const int sl = 8 * g4 + 4 * h + e; const bool ok = (sl <= r);
                                S1[4 * g4 + e] = ok ? S1[4 * g4 + e] * __builtin_amdgcn_exp2f((bt + cv[e]) * LOG2E) : 0.f; } }
                        ha = MFMA32(tr2(vb + 32 * vstr, vb + 40 * vstr), PACK8(S1, 0), ha);
                        ha = MFMA32(tr2(vb + 48 * vstr, vb + 56 * vstr), PACK8(S1, 8), ha);
                    }
                    const float gw = __builtin_amdgcn_exp2f(bt * LOG2E);
                    LAS float* pk_ = (LAS float*)(lds + ML_PARK + w * 8192) + tt * 1024 + lane;
#pragma unroll
                    for (int e = 0; e < 16; ++e) pk_[e * 64] = gw * hi_[e] + ha[e];
                    if (w == 4 && h == 0) den_t[32 * tt + r] = gw * hi_[0] + ha[0];
                }
                bf16x8 vwf[4];
                { const LAS unsigned char* vb = vwb + (8 * h + (li >> 2)) * vstr + (16 * gg + 4 * (li & 3)) * 2;
#pragma unroll
                  for (int sp = 0; sp < 4; ++sp) vwf[sp] = tr2(vb + (16 * sp) * vstr, vb + (16 * sp + 4) * vstr); }
#pragma unroll
                for (int i = 0; i < 4; ++i) {
#pragma unroll
                    for (int e = 0; e < 16; ++e) C[i][e] *= decay;
                    const LAS unsigned char* kb = lds + ML_KT + (8 * h + (li >> 2)) * KROW + (32 * i + 16 * gg + 4 * (li & 3)) * 2;
#pragma unroll
                    for (int sp = 0; sp < 4; ++sp) C[i] = MFMA32(tr2(kb + (16 * sp) * KROW, kb + (16 * sp + 4) * KROW), vwf[sp], C[i]);
                }
            }
            __syncthreads();
            f32x16 res[2];
            if (w < 4) { const LAS float* pk_ = (const LAS float*)(lds + ML_PARK + w * 8192) + lane;
#pragma unroll
                for (int tt = 0; tt < 2; ++tt)
#pragma unroll
                    for (int e = 0; e < 16; ++e) res[tt][e] = pk_[tt * 1024 + e * 64]; }
            {
                if (w < 4) {
#pragma unroll
                    for (int tt = 0; tt < 2; ++tt) { float* np = num_ptr(NB, r0 + 32 * tt + r, hm) + 32 * w + 4 * h;
#pragma unroll
                        for (int g4 = 0; g4 < 4; ++g4) *(f32x4*)(np + 8 * g4) = (f32x4){res[tt][4 * g4], res[tt][4 * g4 + 1], res[tt][4 * g4 + 2], res[tt][4 * g4 + 3]}; }
                } else if (w == 4) { DEN[(r0 + lane) * 4 + hm] = den_t[lane]; }
                else if (w == 5) { BC[(r0 + lane) * 4 + hm] = Bseg + bsum; }
            }
            Bseg += bL;
        }
        if (w < 5) {
#pragma unroll
            for (int i = 0; i < 4; ++i)
#pragma unroll
                for (int e = 0; e < 16; e += 4) *(f32x4*)(FIMG + ((size_t)(st * 5 + w) * 64 + lane) * 64 + i * 16 + e) = (f32x4){C[i][e], C[i][e + 1], C[i][e + 2], C[i][e + 3]};
        }
        if (tid == 0) DSEG[st] = Bseg;
    }
}
__device__ __forceinline__ void mlstm_pass2(const bf16_t* PR, const bf16_t* QC, const float* gain, bf16_t* Y, LAS unsigned char* lds,
                                            float* NB, const float* DEN, const float* BC, const float* FIMG, const float* DSEG, int st_first, int st_stride) {
    const int tid = tid_here(), lane = tid & 63, w = __builtin_amdgcn_readfirstlane(tid >> 6);
    const int r = lane & 31, h = lane >> 5;
    LAS float* cs_t = (LAS float*)(lds + ML_TAB); LAS float* den_t = cs_t + 64; LAS float* ssq_t = cs_t + 128;
    for (int st = st_first; st < 256; st += st_stride) {
        const int b = st >> 4, hm = (st >> 2) & 3, seg = st & 3;
        __syncthreads();
        bf16x8 sf[4][2];
        if (w < 5) {
            f32x16 S[4];
#pragma unroll
            for (int i = 0; i < 4; ++i)
#pragma unroll
                for (int e = 0; e < 16; ++e) S[i][e] = 0.f;
            for (int j = 0; j < seg; ++j) { const int stj = (st & ~3) + j; const float dj = __expf(DSEG[stj]);
#pragma unroll
                for (int i = 0; i < 4; ++i)
#pragma unroll
                    for (int e = 0; e < 16; e += 4) { const f32x4 fv = *(const f32x4*)(FIMG + ((size_t)(stj * 5 + w) * 64 + lane) * 64 + i * 16 + e);
#pragma unroll
                        for (int k = 0; k < 4; ++k) S[i][e + k] = dj * S[i][e + k] + fv[k]; } }
#pragma unroll
            for (int i = 0; i < 4; ++i) { sf[i][0] = PACK8(S[i], 0); sf[i][1] = PACK8(S[i], 8); }
        }
        const size_t rs0 = (size_t)b * SEQL + 64 * (8 * seg);
        const int frow = tid >> 4, fch = tid & 15;
        const bf16_t* pQ = QC + (rs0 + frow) * 512 + hm * 128 + 8 * fch;
        const int wq = (w < 4) ? w : 0;
        const float* pN = num_ptr(NB, rs0 + r, hm) + 32 * wq + 4 * h;
        const bf16_t* pO = PR + (rs0 + r) * PW + PC_OM + hm * 128 + 32 * wq + 4 * h;
        const float* pB = BC + (rs0 + r) * 4 + hm; const float* pD = DEN + (rs0 + r) * 4 + hm;
        f32x4 gv[4];
#pragma unroll
        for (int g4 = 0; g4 < 4; ++g4) gv[g4] = *(const f32x4*)(gain + hm * 128 + 32 * wq + 8 * g4 + 4 * h);
        u32x4 fQ[2]; f32x4 nv[2][4]; u32x2 ov[2][4]; float bcv[2], dnv[2];
#pragma unroll
        for (int p2 = 0; p2 < 2; ++p2) fQ[p2] = *(const u32x4*)(pQ + (size_t)32 * p2 * 512);
#pragma unroll
        for (int tt = 0; tt < 2; ++tt) { bcv[tt] = pB[tt * 32 * 4]; dnv[tt] = pD[tt * 32 * 4];
#pragma unroll
            for (int g4 = 0; g4 < 4; ++g4) { nv[tt][g4] = *(const f32x4*)(pN + (size_t)tt * 32 * 512 + 8 * g4); ov[tt][g4] = *(const u32x2*)(pO + (size_t)tt * 32 * PW + 8 * g4); } }
        for (int cc = 0; cc < 8; ++cc) {
            const size_t r0 = rs0 + 64 * cc;
#pragma unroll
            for (int p2 = 0; p2 < 2; ++p2) *(LAS u32x4*)(lds + ML_QT + (frow + 32 * p2) * KROW + 16 * fch) = fQ[p2];
            __syncthreads();
            if (cc < 7) { pQ += 64 * 512;
#pragma unroll
                for (int p2 = 0; p2 < 2; ++p2) fQ[p2] = *(const u32x4*)(pQ + (size_t)32 * p2 * 512); }
            f32x16 res[2];
            if (w < 5) {
#pragma unroll
                for (int tt = 0; tt < 2; ++tt) {
                    const LAS unsigned char* qb0 = lds + ML_QT + (32 * tt + r) * KROW + 8 * h;
                    f32x16 acc;
#pragma unroll
                    for (int e = 0; e < 16; ++e) acc[e] = 0.f;
#pragma unroll
                    for (int i = 0; i < 4; ++i)
#pragma unroll
                        for (int s = 0; s < 2; ++s) acc = MFMA32(sf[i][s], lds2x8(qb0 + 64 * i + 32 * s, qb0 + 64 * i + 32 * s + 16), acc);
                    const float gwt = __expf(bcv[tt]);
                    if (w < 4) {
#pragma unroll
                        for (int g4 = 0; g4 < 4; ++g4)
#pragma unroll
                            for (int e = 0; e < 4; ++e) res[tt][4 * g4 + e] = nv[tt][g4][e] + gwt * acc[4 * g4 + e]; }
                    else if (h == 0) den_t[32 * tt + r] = dnv[tt] + gwt * acc[0];
                }
            }
            if (cc < 7) { pN += (size_t)64 * 512; pB += 64 * 4; pD += 64 * 4;
#pragma unroll
                for (int tt = 0; tt < 2; ++tt) { bcv[tt] = pB[tt * 32 * 4]; dnv[tt] = pD[tt * 32 * 4];
#pragma unroll
                    for (int g4 = 0; g4 < 4; ++g4) nv[tt][g4] = *(const f32x4*)(pN + (size_t)tt * 32 * 512 + 8 * g4); } }
            __syncthreads();
            if (w < 4) {
#pragma unroll
                for (int tt = 0; tt < 2; ++tt) {
                    const float dd = 1.f / fmaxf(fabsf(den_t[32 * tt + r]), 1.f); float ss = 0.f;
#pragma unroll
                    for (int g4 = 0; g4 < 4; ++g4) { const u32x2 o2 = ov[tt][g4];
                        const float og[4] = {__uint_as_float(o2.x << 16), __uint_as_float(o2.x & 0xffff0000u), __uint_as_float(o2.y << 16), __uint_as_float(o2.y & 0xffff0000u)};
#pragma unroll
                        for (int e = 0; e < 4; ++e) { const float v = res[tt][4 * g4 + e] * dd * sigmoid_f(og[e]); res[tt][4 * g4 + e] = v; ss += v * v; } }
                    ss += __shfl_xor(ss, 32);
                    if (h == 0) ssq_t[64 * w + 32 * tt + r] = ss;
                }
            }
            if (cc < 7) { pO += (size_t)64 * PW;
#pragma unroll
                for (int tt = 0; tt < 2; ++tt)
#pragma unroll
                    for (int g4 = 0; g4 < 4; ++g4) ov[tt][g4] = *(const u32x2*)(pO + (size_t)tt * 32 * PW + 8 * g4); }
            __syncthreads();
            if (w < 4) {
#pragma unroll
                for (int tt = 0; tt < 2; ++tt) {
                    const int t = 32 * tt + r;
                    const float rr = rsqrtf(((ssq_t[t] + ssq_t[64 + t]) + (ssq_t[128 + t] + ssq_t[192 + t])) * (1.f / 128.f) + EPS);
#pragma unroll
                    for (int g4 = 0; g4 < 4; ++g4) { const int d0 = hm * 128 + 32 * w + 8 * g4 + 4 * h;
                        u32x2 o; o.x = pk2(res[tt][4 * g4] * rr * gv[g4][0], res[tt][4 * g4 + 1] * rr * gv[g4][1]); o.y = pk2(res[tt][4 * g4 + 2] * rr * gv[g4][2], res[tt][4 * g4 + 3] * rr * gv[g4][3]);
                        *(u32x2*)(Y + (r0 + t) * DM + 512 + d0) = o; }
                }
            }
        }
    }
}

__global__ void __launch_bounds__(512, 2) mega(Args a) {
    extern __shared__ __attribute__((aligned(16))) unsigned char lds_raw[];
    LAS unsigned char* lds = (LAS unsigned char*)lds_raw;
    cg::grid_group grid = cg::this_grid();
    unsigned char* ws = a.ws;
    bf16_t* XN = (bf16_t*)(ws + WS_XN); bf16_t* HB = (bf16_t*)(ws + WS_H); bf16_t* PR = (bf16_t*)(ws + WS_H); bf16_t* Y = (bf16_t*)a.out; bf16_t* XN3 = (bf16_t*)(ws + WS_XN3);
    float* SS2 = (float*)(ws + WS_SS2); float* SS3 = (float*)(ws + WS_SS3); float* GT = (float*)(ws + WS_G);
    const int G = gridDim.x, bx = blockIdx.x;
    volatile LAS unsigned* MISC = (volatile LAS unsigned*)(lds + 131072 + 320);
    if (threadIdx.x < 32) MISC[threadIdx.x] = 0u;
    __syncthreads();
    if (a.ws == nullptr) grid.sync();
    const XcdBarrier bar = xcd_barrier_post((unsigned*)(ws + WS_BAR), MISC + 8);
    prologue(a, lds);
    xcd_barrier(bar);
#if PROBE_DUP & 1
    prologue(a, lds);
    xcd_barrier(bar);
#endif
#if PROBE_DUP & 32
    for (int i = 0; i < 8; ++i) xcd_barrier(bar);
#endif
    { pg8::Gemm g{XN, (const bf16_t*)(ws + WS_WG1), MTOK, NGU, 1024}; pg8::StaticOrder S; S.init(MTOK, NGU, G, bx); EpiSwiGLU E{HB, nullptr};
      pg8::gemm_phase<EpiSwiGLU, pg8::StaticOrder, true, true>(lds, g, S, E); }
    xcd_barrier(bar);
    { pg8::Gemm g{HB, (const bf16_t*)(ws + WS_WD1), MTOK, DM, DFF}; pg8::StaticOrder S; S.init(MTOK, DM, G, bx); EpiResG<false, true> E{a.in[I_X], XN, 0.5f, SS2};
      pg8::gemm_phase<EpiResG<false, true>, pg8::StaticOrder, true, true>(lds, g, S, E); }
    xcd_barrier(bar);
    { pg8::Gemm g{XN, (const bf16_t*)(ws + WS_WIN), MTOK, PW, 1024}; pg8::StaticOrder S; S.init(MTOK, PW, G, bx); EpiProj E{PR, GT, SS2, a.in[I_QNW], a.in[I_KNW], a.in[I_IB], a.in[I_FB]};
      pg8::gemm_phase<EpiProj, pg8::StaticOrder, true, true>(lds, g, S, E);
      gates_job(XN, (const bf16_t*)(ws + WS_WIN), SS2, a.in[I_IB], a.in[I_FB], GT, lds); }
    xcd_barrier(bar);
#define WSP(T, off) ((T*)(wsl + (off)))
#define NUMB ((float*)a.out + (size_t)16 * 1024 * 1024)
    {
        unsigned char* wsl = ws; asm volatile("" : "+s"(wsl));
        for (int st = bx; st < 256; st += G) {
            conv_local(WSP(bf16_t, WS_H), a.in[I_CW], a.in[I_CB], WSP(bf16_t, WS_QC), WSP(bf16_t, WS_KC), st);
            __syncthreads();
            mlstm_pass1(WSP(bf16_t, WS_H), WSP(bf16_t, WS_QC), WSP(bf16_t, WS_KC), WSP(float, WS_G), a.in[I_MG], (bf16_t*)a.out, lds, NUMB, WSP(float, WS_DEN), WSP(float, WS_BC), WSP(float, WS_FIMG), WSP(float, WS_DSEG), st, 256);
            __syncthreads();
        }
    }
    {
        unsigned char* wsl = ws; asm volatile("" : "+s"(wsl));
        const int tid4 = tid_here(); const int lane = tid4 & 63, wave = __builtin_amdgcn_readfirstlane(tid4 >> 6);
        LAS unsigned char* vl = lds + wave * 9216;
        for (int task = bx * 8 + wave; task < 16384; task += G * 8) {
            const int br = task >> 13, tk = task & 8191, bh = tk >> 6, wq = tk & 63;
            attn_task<0>(WSP(bf16_t, WS_H), bh >> 3, bh & 7, br ? (wq >> 2) : (wq >> 4), br ? 16 : 4, br ? (wq & 3) : (wq & 15), vl, br ? WSP(bf16_t, WS_P16) : WSP(bf16_t, WS_P4), br ? WSP(float, WS_L16) : WSP(float, WS_L4),
                         nullptr, nullptr, nullptr, nullptr, nullptr, nullptr, lane);
        }
    }
    xcd_barrier(bar);
    {
        unsigned char* wsl = ws; asm volatile("" : "+s"(wsl));
        mlstm_pass2(WSP(bf16_t, WS_H), WSP(bf16_t, WS_QC), a.in[I_MG], (bf16_t*)a.out, lds, NUMB, WSP(float, WS_DEN), WSP(float, WS_BC), WSP(float, WS_FIMG), WSP(float, WS_DSEG), bx, G);
        __syncthreads();
    }
    {
        unsigned char* wsl = ws; asm volatile("" : "+s"(wsl));
        const int tid4 = tid_here(); const int lane = tid4 & 63, wave = __builtin_amdgcn_readfirstlane(tid4 >> 6);
        LAS unsigned char* vl = lds + wave * 9216;
        for (int task = bx * 8 + wave; task < 8192; task += G * 8) { const int bh = task >> 6, wq = task & 63;
            attn_task<1>(WSP(bf16_t, WS_H), bh >> 3, bh & 7, 0, 1, wq, vl, nullptr, nullptr, WSP(bf16_t, WS_P4), WSP(bf16_t, WS_P16), WSP(float, WS_L4), WSP(float, WS_L16), a.in[I_AG], (bf16_t*)a.out, lane); }
    }
#undef NUMB
#undef WSP
    xcd_barrier(bar);
    { pg8::Gemm g{Y, (const bf16_t*)(ws + WS_WOUT), MTOK, DM, 1024}; pg8::StaticOrder S; S.init(MTOK, DM, G, bx); EpiResG<true, true> E{XN, XN3, 1.0f, SS3};
      pg8::gemm_phase<EpiResG<true, true>, pg8::StaticOrder, true, true>(lds, g, S, E); }
    xcd_barrier(bar);
    { pg8::Gemm g{XN3, (const bf16_t*)(ws + WS_WG2), MTOK, NGU, 1024}; pg8::StaticOrder S; S.init(MTOK, NGU, G, bx); EpiSwiGLU E{HB, SS3};
      pg8::gemm_phase<EpiSwiGLU, pg8::StaticOrder, true, true>(lds, g, S, E); }
    xcd_barrier(bar);
    { pg8::Gemm g{HB, (const bf16_t*)(ws + WS_WD2), MTOK, DM, DFF}; pg8::StaticOrder S; S.init(MTOK, DM, G, bx); EpiResG<true, false> E{XN3, a.out, 0.5f, nullptr};
      pg8::gemm_phase<EpiResG<true, false>, pg8::StaticOrder, true, true>(lds, g, S, E); }
}

extern "C" void kernel_launch(void* const* d_in, const int* in_sizes, int n_in, void* d_out, int out_size, void* d_ws, size_t ws_size, hipStream_t stream) {
    static int grid = 0;
    if (grid == 0) {
        int dev = 0, cus = 0, per_cu = 0;
        (void)hipGetDevice(&dev); (void)hipDeviceGetAttribute(&cus, hipDeviceAttributeMultiprocessorCount, dev);
        if (hipFuncSetAttribute((const void*)mega, hipFuncAttributeMaxDynamicSharedMemorySize, LDS_BYTES) != hipSuccess) fprintf(stderr, "kernel_launch: hipFuncSetAttribute failed\n");
        if (hipOccupancyMaxActiveBlocksPerMultiprocessor(&per_cu, (const void*)mega, 512, LDS_BYTES) != hipSuccess || per_cu < 1) fprintf(stderr, "kernel_launch: occupancy query says %d\n", per_cu);
        (void)hipGetLastError();
        if (cus <= 0) cus = 256;
        grid = cus;
        if (n_in != 20 || ws_size < WS_END) fprintf(stderr, "kernel_launch: unexpected n_in %d / ws %zu\n", n_in, ws_size);
    }
    Args a{};
    for (int i = 0; i < 20; ++i) a.in[i] = (const float*)d_in[i];
    a.out = (float*)d_out; a.ws = (unsigned char*)d_ws;
    if (hipMemsetAsync((char*)d_ws + WS_BAR, 0, 16384, stream) != hipSuccess) fprintf(stderr, "kernel_launch: memset of the barrier words failed\n");
    void* args[] = {&a};
    hipError_t e = hipLaunchCooperativeKernel((const void*)mega, dim3(grid), dim3(512), args, LDS_BYTES, stream);
    if (e != hipSuccess) fprintf(stderr, "kernel_launch: cooperative launch failed: %s (grid %d)\n", hipGetErrorString(e), grid);
}
```

```cpp
#include <hip/hip_runtime.h>
#include <hip/hip_cooperative_groups.h>
#include <cstdio>
#include <cstdint>
namespace cg = cooperative_groups;
#ifndef USE_NAIVE_ATTN
#define USE_NAIVE_ATTN 0
#endif
#ifndef USE_NAIVE_MLSTM
#define USE_NAIVE_MLSTM 0
#endif
#ifndef PROBE_DUP
#define PROBE_DUP 0
#endif
#ifndef REP0
#define REP0 1
#endif
#ifndef REP1
#define REP1 1
#endif
#ifndef REP3
#define REP3 1
#endif
#ifndef REP4A
#define REP4A 1
#endif
#ifndef REP4B
#define REP4B 1
#endif
#ifndef REP4C
#define REP4C 1
#endif
namespace pg8 {
#define PG8_LAS __attribute__((address_space(3)))
typedef unsigned short bf16_t;
typedef short bf16x8 __attribute__((ext_vector_type(8)));
typedef float f32x4 __attribute__((ext_vector_type(4)));
typedef unsigned u32x4 __attribute__((ext_vector_type(4)));
constexpr int BM = 256, BK = 64, HALF = 128, HTB = HALF * BK * 2  , STAGE_BYTES = 8 * HTB, NXCD = 8, WGM = 2;

__host__ __device__ __forceinline__ int lds_byte(int r, int c) { const int st = (r >> 4) * 2 + (c >> 5), rr = r & 15, cc = c & 31, ob = rr * 64 + cc * 2; return st * 1024 + (ob ^ (((ob >> 9) & 1) << 5)); }
__host__ __device__ __forceinline__ void stage_rc(int b, int& R, int& C) { const int st = b / 1024, sb = b % 1024, swz = sb ^ (((sb >> 9) & 1) << 5); R = (st >> 1) * 16 + swz / 64; C = (st & 1) * 32 + (swz % 64) / 2; }
__host__ __device__ __forceinline__ int perm32(int rho) { const int n = rho >> 4, i = rho & 15; return 8 * (i >> 2) + 4 * n + (i & 3); }

struct Unit { int pm, pn; };
struct Gemm { const bf16_t* A; const bf16_t* Bt; int M, N, K; };

struct StaticOrder {
    int nM, nN, nwg, G, c;
    __host__ __device__ void init(int M, int N, int G_, int c_) { nM = M / BM; nN = N / BM; nwg = nM * nN; G = G_; c = c_; }
    __host__ __device__ bool next(int i, Unit& u) const {
        const long L = (long)i * G + c; if (L >= nwg) return false;
        int wgid = (int)L; { const int q = nwg / NXCD, r = nwg % NXCD, xcd = wgid % NXCD, off = wgid / NXCD; wgid = (xcd < r ? xcd * (q + 1) : r * (q + 1) + (xcd - r) * q) + off; }
        const int nig = WGM * nN, gid = wgid / nig, fm = gid * WGM, gsz = (nM - fm) < WGM ? (nM - fm) : WGM;
        u.pm = fm + ((wgid % nig) % gsz); u.pn = (wgid % nig) / gsz; return true;
    }
    __device__ __forceinline__ void a_ready(const Unit&) const {}
    __device__ __forceinline__ void done(const Unit&) const {}
};

__device__ __forceinline__ unsigned cvt_pk_bf16(float lo, float hi) { unsigned r; asm volatile("v_cvt_pk_bf16_f32 %0, %1, %2" : "=v"(r) : "v"(lo), "v"(hi)); return r; }
typedef float f32x2 __attribute__((ext_vector_type(2)));
template <class Epi, class Sched, bool ALIGN_EPI = false, bool SP2 = false>
__device__ __forceinline__ void gemm_phase(PG8_LAS unsigned char* lds, const Gemm g, const Sched& S, const Epi& E) {
    int tid = threadIdx.x; asm volatile("" : "+v"(tid));
    const int wid = __builtin_amdgcn_readfirstlane(tid >> 6), lane = tid & 63, wr = wid >> 2, wc = wid & 3, fr = lane & 15, fq = lane >> 4;
    const int K = g.K, nt = K / BK;
    unsigned voffA[2], voffB[2];
#pragma unroll
    for (int i = 0; i < 2; ++i) { int R, C; stage_rc(tid * 16 + i * 8192, R, C); const int Rb = Epi::PERM ? ((R & ~31) + perm32(R & 31)) : R;
        voffA[i] = (unsigned)(R * K + C) * 2u; voffB[i] = (unsigned)(Rb * K + C) * 2u; }
    const size_t kstep = (size_t)(BK * 2);
    const size_t hstep = (size_t)HALF * K * 2;
    const size_t tstep = 2 * hstep;
    const unsigned ldsw = (unsigned)wid * 1024u;
    const int aoff = lds_byte(wr * 64 + fr, fq * 8), boff = lds_byte(wc * 32 + fr, fq * 8);
#define PG8_SA(b, h) (((b) * 2 + (h)) * HTB)
#define PG8_SB(b, h) ((4 + (b) * 2 + (h)) * HTB)
#define PG8_STAGE(bufoff, gbase, voff) do { _Pragma("unroll") for (int _i = 0; _i < 2; ++_i) \
        __builtin_amdgcn_global_load_lds((const unsigned*)((const char*)(gbase) + (voff)[_i]), (PG8_LAS unsigned*)(lds + (bufoff) + ldsw + _i * 8192), 16, 0, 0); } while (0)
#define PG8_LDA(dst, b, h) do { _Pragma("unroll") for (int m = 0; m < 4; ++m) _Pragma("unroll") for (int k = 0; k < 2; ++k) dst[m][k] = *(const PG8_LAS bf16x8*)(lds + PG8_SA(b, h) + aoff + m * 2048 + k * 1024); } while (0)
#define PG8_LDB(dst, b, h) do { _Pragma("unroll") for (int n = 0; n < 2; ++n) _Pragma("unroll") for (int k = 0; k < 2; ++k) dst[n][k] = *(const PG8_LAS bf16x8*)(lds + PG8_SB(b, h) + boff + n * 2048 + k * 1024); } while (0)
#define PG8_MMA(ai, bj, At, Bt) do { __builtin_amdgcn_s_setprio(1); _Pragma("unroll") for (int m = 0; m < 4; ++m) _Pragma("unroll") for (int n = 0; n < 2; ++n) _Pragma("unroll") for (int k = 0; k < 2; ++k) \
        acc[ai][bj][m][n] = __builtin_amdgcn_mfma_f32_16x16x32_bf16(Bt[n][k], At[m][k], acc[ai][bj][m][n], 0, 0, 0); __builtin_amdgcn_s_setprio(0); } while (0)
#define PG8_WAIT_V(n) asm volatile("s_waitcnt vmcnt(" #n ")" ::: "memory")
#define PG8_WAIT_L(n) asm volatile("s_waitcnt lgkmcnt(" #n ")" ::: "memory")
#define PG8_BAR __builtin_amdgcn_s_barrier()
#define PG8_SCHED __builtin_amdgcn_sched_barrier(0)
    Unit cur, nxt; int ui = 0;
    if (!S.next(0, cur)) return;
    f32x4 acc[2][2][4][2];
#pragma unroll
    for (int a = 0; a < 2; ++a)
#pragma unroll
        for (int b = 0; b < 2; ++b)
#pragma unroll
            for (int m = 0; m < 4; ++m)
#pragma unroll
                for (int n = 0; n < 2; ++n) acc[a][b][m][n] = (f32x4){0.f, 0.f, 0.f, 0.f};
    bf16x8 At[4][2], B0[2][2], B1[2][2];
    const char* cA = (const char*)g.A + (size_t)cur.pm * tstep; const char* cB = (const char*)g.Bt + (size_t)cur.pn * tstep;
    S.a_ready(cur);
    if constexpr (SP2) {
        PG8_STAGE(PG8_SB(0, 0), cB, voffB); PG8_STAGE(PG8_SB(0, 1), cB + hstep, voffB); PG8_STAGE(PG8_SA(0, 0), cA, voffA); PG8_STAGE(PG8_SA(0, 1), cA + hstep, voffA);
        if (wr == 1) PG8_BAR;
        PG8_WAIT_V(2); PG8_BAR;
        PG8_STAGE(PG8_SB(1, 0), cB + kstep, voffB); PG8_STAGE(PG8_SA(1, 0), cA + kstep, voffA); PG8_STAGE(PG8_SB(1, 1), cB + hstep + kstep, voffB);
        PG8_WAIT_V(6); PG8_BAR;
    } else {
        PG8_STAGE(PG8_SB(0, 0), cB, voffB); PG8_STAGE(PG8_SA(0, 0), cA, voffA); PG8_STAGE(PG8_SB(0, 1), cB + hstep, voffB); PG8_STAGE(PG8_SA(0, 1), cA + hstep, voffA);
        if (wr == 1) PG8_BAR;
        PG8_WAIT_V(4); PG8_BAR;
        PG8_STAGE(PG8_SB(1, 0), cB + kstep, voffB); PG8_STAGE(PG8_SA(1, 0), cA + kstep, voffA); PG8_STAGE(PG8_SB(1, 1), cB + hstep + kstep, voffB);
        PG8_WAIT_V(6); PG8_BAR;
    }
    for (;;) {
        const bool has_next = S.next(ui + 1, nxt);
        const char* nA = has_next ? (const char*)g.A + (size_t)nxt.pm * tstep : cA; const char* nB = has_next ? (const char*)g.Bt + (size_t)nxt.pn * tstep : cB;
        for (int t = 0; t < nt; t += 2) {
            const bool last = (t == nt - 2);
            const char* a1 = cA + (size_t)(t + 1) * kstep;
            const char* a2 = last ? nA : cA + (size_t)(t + 2) * kstep; const char* b2 = last ? nB : cB + (size_t)(t + 2) * kstep;
            const char* a3 = a2 + kstep; const char* b3 = b2 + kstep;
            if (last && has_next) S.a_ready(nxt);
            if constexpr (SP2) {
            PG8_LDB(B0, 0, 0); PG8_LDB(B1, 0, 1); PG8_SCHED; PG8_LDA(At, 0, 0); PG8_STAGE(PG8_SA(1, 1), a1 + hstep, voffA);
            PG8_WAIT_V(8); PG8_WAIT_L(0); PG8_BAR; PG8_MMA(0, 0, At, B0); PG8_MMA(0, 1, At, B1); PG8_BAR; PG8_SCHED;
            PG8_LDA(At, 0, 1); PG8_STAGE(PG8_SB(0, 0), b2, voffB); PG8_STAGE(PG8_SB(0, 1), b2 + hstep, voffB); PG8_STAGE(PG8_SA(0, 0), a2, voffA);
            PG8_WAIT_V(8); PG8_WAIT_L(0); PG8_BAR; PG8_MMA(1, 0, At, B0); PG8_MMA(1, 1, At, B1); PG8_BAR; PG8_SCHED;
            PG8_LDB(B0, 1, 0); PG8_LDB(B1, 1, 1); PG8_SCHED; PG8_LDA(At, 1, 0); PG8_STAGE(PG8_SA(0, 1), a2 + hstep, voffA);
            PG8_WAIT_V(8); PG8_WAIT_L(0); PG8_BAR; PG8_MMA(0, 0, At, B0); PG8_MMA(0, 1, At, B1); PG8_BAR; PG8_SCHED;
            PG8_LDA(At, 1, 1); PG8_STAGE(PG8_SB(1, 0), b3, voffB); PG8_STAGE(PG8_SB(1, 1), b3 + hstep, voffB); PG8_STAGE(PG8_SA(1, 0), a3, voffA);
            PG8_WAIT_V(8); PG8_WAIT_L(0); PG8_BAR; PG8_MMA(1, 0, At, B0); PG8_MMA(1, 1, At, B1); PG8_BAR; PG8_SCHED;
            } else {
            PG8_LDB(B0, 0, 0); PG8_SCHED; PG8_LDA(At, 0, 0); PG8_STAGE(PG8_SA(1, 1), a1 + hstep, voffA);
            PG8_WAIT_L(8); PG8_BAR; PG8_WAIT_L(0); PG8_MMA(0, 0, At, B0); PG8_BAR; PG8_SCHED;
            PG8_LDB(B1, 0, 1); PG8_STAGE(PG8_SB(0, 0), b2, voffB);
            PG8_BAR; PG8_WAIT_L(0); PG8_MMA(0, 1, At, B1); PG8_BAR;
            PG8_LDA(At, 0, 1); PG8_STAGE(PG8_SA(0, 0), a2, voffA);
            PG8_BAR; PG8_WAIT_L(0); PG8_MMA(1, 0, At, B0); PG8_BAR; PG8_SCHED;
            PG8_STAGE(PG8_SB(0, 1), b2 + hstep, voffB);
            PG8_WAIT_V(6); PG8_BAR; PG8_MMA(1, 1, At, B1); PG8_BAR;
            PG8_LDB(B0, 1, 0); PG8_SCHED; PG8_LDA(At, 1, 0); PG8_STAGE(PG8_SA(0, 1), a2 + hstep, voffA);
            PG8_WAIT_L(8); PG8_BAR; PG8_WAIT_L(0); PG8_MMA(0, 0, At, B0); PG8_BAR; PG8_SCHED;
            PG8_LDB(B1, 1, 1); PG8_STAGE(PG8_SB(1, 0), b3, voffB);
            PG8_BAR; PG8_WAIT_L(0); PG8_MMA(0, 1, At, B1); PG8_BAR;
            PG8_LDA(At, 1, 1); PG8_STAGE(PG8_SA(1, 0), a3, voffA);
            PG8_BAR; PG8_WAIT_L(0); PG8_MMA(1, 0, At, B0); PG8_BAR; PG8_SCHED;
            PG8_STAGE(PG8_SB(1, 1), b3 + hstep, voffB);
            PG8_WAIT_V(6); PG8_BAR; PG8_MMA(1, 1, At, B1); PG8_BAR;
            }
        }
        if constexpr (ALIGN_EPI) { if (wr == 0) PG8_BAR; }
        if constexpr (!Epi::AFTER_DRAIN) { E(acc, cur, wr, wc, fr, fq); S.done(cur); }
        if (!has_next) break;
#pragma unroll
        for (int a = 0; a < 2; ++a)
#pragma unroll
            for (int b = 0; b < 2; ++b)
#pragma unroll
                for (int m = 0; m < 4; ++m)
#pragma unroll
                    for (int n = 0; n < 2; ++n) acc[a][b][m][n] = (f32x4){0.f, 0.f, 0.f, 0.f};
        cur = nxt; cA = nA; cB = nB; ++ui;
        if constexpr (ALIGN_EPI) { if (wr == 1) PG8_BAR; }
    }
    PG8_WAIT_V(0);
    if constexpr (!ALIGN_EPI) { if (wr == 0) PG8_BAR; }
    PG8_BAR;
    if constexpr (Epi::AFTER_DRAIN) { E.fused(acc, cur, wr, wc, fr, fq, lds, wid, lane); S.done(cur); }
#undef PG8_SA
#undef PG8_SB
#undef PG8_STAGE
#undef PG8_LDA
#undef PG8_LDB
#undef PG8_MMA
#undef PG8_WAIT_V
#undef PG8_WAIT_L
#undef PG8_BAR
#undef PG8_SCHED
}
}

#define LAS __attribute__((address_space(3)))
typedef pg8::bf16_t bf16_t;
typedef pg8::f32x4 f32x4;
typedef pg8::u32x4 u32x4;
typedef pg8::bf16x8 bf16x8;
typedef unsigned u32x2 __attribute__((ext_vector_type(2)));
constexpr int MTOK = 32768, SEQL = 2048, DM = 1024, DFF = 2816, NGU = 2 * DFF, DINP = 3840, DIN = 3592, PW = 3584;
constexpr float EPS = 1e-6f, LOG2E = 1.4426950408889634f;
constexpr size_t MiB = 1u << 20;
constexpr size_t WS_SS2 = 0, WS_SS3 = 128 * 1024, WS_BAR = 512 * 1024;
constexpr size_t WS_WG1 = 2 * MiB, WS_WD1 = 14 * MiB, WS_WG2 = 20 * MiB, WS_WD2 = 32 * MiB, WS_WIN = 38 * MiB, WS_WOUT = 46 * MiB;
constexpr size_t WS_XN = 48 * MiB, WS_H = 112 * MiB, WS_G = 336 * MiB, WS_P4 = 337 * MiB, WS_P16 = 369 * MiB, WS_L4 = 401 * MiB, WS_L16 = 402 * MiB;
constexpr size_t WS_QC = 403 * MiB, WS_KC = 435 * MiB, WS_XN3 = WS_QC, WS_DEN = 467 * MiB, WS_BC = 468 * MiB, WS_DSEG = 469 * MiB, WS_FIMG = 470 * MiB, WS_END = 492 * MiB;
constexpr int PC_QA = 0, PC_KA = 512, PC_VA = 1024, PC_QM = 1536, PC_KM = 2048, PC_VM = 2560, PC_OM = 3072;
constexpr int LDS_BYTES = 147456;

__device__ __forceinline__ int tid_here() { int t = threadIdx.x; asm volatile("" : "+v"(t)); return t; }
__device__ __forceinline__ float bf2f(unsigned short b) { return __uint_as_float((unsigned)b << 16); }
__device__ __forceinline__ unsigned pk2(float lo, float hi) { return pg8::cvt_pk_bf16(lo, hi); }
__device__ __forceinline__ unsigned short f2bf1(float f) { return (unsigned short)(pk2(f, 0.f) & 0xffffu); }
__device__ __forceinline__ float sigmoid_f(float x) { return __builtin_amdgcn_rcpf(1.f + __builtin_amdgcn_exp2f(-x * LOG2E)); }
__device__ __forceinline__ float silu_f(float x) { return x * sigmoid_f(x); }
__device__ __forceinline__ float wave_sum(float v) {
#pragma unroll
    for (int o = 1; o < 64; o <<= 1) v += __shfl_xor(v, o);
    return v;
}

template <int CTRL, int RMASK> __device__ __forceinline__ float dpp_mov0(float x) { return __int_as_float(__builtin_amdgcn_update_dpp(0, __float_as_int(x), CTRL, RMASK, 0xF, true)); }
__device__ __forceinline__ float wave_incl_scan(float x) {
    x += dpp_mov0<0x111, 0xF>(x); x += dpp_mov0<0x112, 0xF>(x); x += dpp_mov0<0x114, 0xF>(x); x += dpp_mov0<0x118, 0xF>(x);
    x += dpp_mov0<0x142, 0xA>(x);
    x += dpp_mov0<0x143, 0xC>(x);
    return x;
}
struct EpiSwiGLU {
    static constexpr bool PERM = true, AFTER_DRAIN = false;
    bf16_t* H; const float* sumsq;
    __device__ __forceinline__ void operator()(const f32x4 (&acc)[2][2][4][2], const pg8::Unit& u, int wr, int wc, int fr, int fq) const {
        const int row0 = u.pm * 256 + wr * 64 + fr, col = u.pn * 128 + wc * 32 + 8 * fq;
#pragma unroll
        for (int ai = 0; ai < 2; ++ai)
#pragma unroll
            for (int m = 0; m < 4; ++m) {
                const int row = row0 + ai * 128 + m * 16;
                const float rs = sumsq ? rsqrtf(sumsq[row] * (1.f / 1024.f) + EPS) : 1.f;
                float o[8];
#pragma unroll
                for (int n = 0; n < 2; ++n)
#pragma unroll
                    for (int e = 0; e < 4; ++e) { const float g = acc[ai][0][m][n][e] * rs, up = acc[ai][1][m][n][e] * rs; o[4 * n + e] = silu_f(g) * up; }
                u32x4 w; w.x = pk2(o[0], o[1]); w.y = pk2(o[2], o[3]); w.z = pk2(o[4], o[5]); w.w = pk2(o[6], o[7]);
                *(u32x4*)(H + (size_t)row * DFF + col) = w;
            }
    }
};
struct EpiResid {
    static constexpr bool PERM = false, AFTER_DRAIN = false;
    const float* base; float* out; float alpha; bf16_t* xw; const float* wn; float* sumsq;
    __device__ __forceinline__ void operator()(const f32x4 (&acc)[2][2][4][2], const pg8::Unit& u, int wr, int wc, int fr, int fq) const {
        const int row0 = u.pm * 256 + wr * 64 + fr, col0 = u.pn * 256 + wc * 32 + 4 * fq;
#pragma unroll
        for (int ai = 0; ai < 2; ++ai)
#pragma unroll
            for (int m = 0; m < 4; ++m) {
                const int row = row0 + ai * 128 + m * 16; float ss = 0.f;
#pragma unroll
                for (int bj = 0; bj < 2; ++bj)
#pragma unroll
                    for (int n = 0; n < 2; ++n) {
                        const size_t off = (size_t)row * DM + col0 + bj * 128 + n * 16;
                        const f32x4 b = *(const f32x4*)(base + off); const f32x4 o = b + acc[ai][bj][m][n] * alpha;
                        *(f32x4*)(out + off) = o;
                        if (xw) { ss += (o[0] * o[0] + o[1] * o[1]) + (o[2] * o[2] + o[3] * o[3]);
                            const f32x4 wv = *(const f32x4*)(wn + col0 + bj * 128 + n * 16);
                            u32x2 w; w.x = pk2(o[0] * wv[0], o[1] * wv[1]); w.y = pk2(o[2] * wv[2], o[3] * wv[3]); *(u32x2*)(xw + off) = w; }
                    }
                if (xw) { ss += __shfl_xor(ss, 16); ss += __shfl_xor(ss, 32); if (fq == 0) atomicAdd(sumsq + row, ss); }
            }
    }
};
template <bool BASE_BF16, bool OUT_BF16>
struct EpiResG {
    static constexpr bool PERM = true, AFTER_DRAIN = false;
    const void* base; void* out; float alpha; float* sumsq;
    __device__ __forceinline__ void operator()(const f32x4 (&acc)[2][2][4][2], const pg8::Unit& u, int wr, int wc, int fr, int fq) const {
        const int row0 = u.pm * 256 + wr * 64 + fr, col0 = u.pn * 256 + wc * 32 + 8 * fq;
#pragma unroll
        for (int ai = 0; ai < 2; ++ai)
#pragma unroll
            for (int m = 0; m < 4; ++m) {
                const int row = row0 + ai * 128 + m * 16; float ss = 0.f;
#pragma unroll
                for (int bj = 0; bj < 2; ++bj) {
                    const size_t off = (size_t)row * DM + col0 + bj * 128;
                    float o[8];
                    if (BASE_BF16) { const u32x4 bw = *(const u32x4*)((const bf16_t*)base + off);
#pragma unroll
                        for (int e = 0; e < 4; ++e) { o[2 * e] = __uint_as_float(bw[e] << 16); o[2 * e + 1] = __uint_as_float(bw[e] & 0xffff0000u); } }
                    else { const f32x4 b0 = *(const f32x4*)((const float*)base + off), b1 = *(const f32x4*)((const float*)base + off + 4);
#pragma unroll
                        for (int e = 0; e < 4; ++e) { o[e] = b0[e]; o[4 + e] = b1[e]; } }
#pragma unroll
                    for (int n = 0; n < 2; ++n)
#pragma unroll
                        for (int e = 0; e < 4; ++e) { const float v = o[4 * n + e] + alpha * acc[ai][bj][m][n][e]; o[4 * n + e] = v; ss += v * v; }
                    if (OUT_BF16) { u32x4 w; w.x = pk2(o[0], o[1]); w.y = pk2(o[2], o[3]); w.z = pk2(o[4], o[5]); w.w = pk2(o[6], o[7]); *(u32x4*)((bf16_t*)out + off) = w; }
                    else { *(f32x4*)((float*)out + off) = (f32x4){o[0], o[1], o[2], o[3]}; *(f32x4*)((float*)out + off + 4) = (f32x4){o[4], o[5], o[6], o[7]}; }
                }
                if (sumsq) { ss += __shfl_xor(ss, 16); ss += __shfl_xor(ss, 32); if (fq == 0) atomicAdd(sumsq + row, ss); }
            }
    }
};
struct EpiProj {
    static constexpr bool PERM = true, AFTER_DRAIN = false;
    bf16_t* P; float* G; const float* sumsq; const float* qw; const float* kw; const float* ib; const float* fb;
    __device__ __forceinline__ void operator()(const f32x4 (&acc)[2][2][4][2], const pg8::Unit& u, int wr, int wc, int fr, int fq) const {
        const int row0 = u.pm * 256 + wr * 64 + fr;
        if (u.pn < 4) {
            const float* w = (u.pn < 2) ? qw : kw; const float sc = (u.pn < 2) ? 0.125f * LOG2E : 1.f;
            f32x4 wv[2][2];
#pragma unroll
            for (int bj = 0; bj < 2; ++bj)
#pragma unroll
                for (int n = 0; n < 2; ++n) wv[bj][n] = *(const f32x4*)(w + 32 * bj + 8 * fq + 4 * n);
#pragma unroll
            for (int ai = 0; ai < 2; ++ai)
#pragma unroll
                for (int m = 0; m < 4; ++m) {
                    const int row = row0 + ai * 128 + m * 16;
                    const float rs = rsqrtf(sumsq[row] * (1.f / 1024.f) + EPS);
                    f32x4 v[2][2]; float ss = 0.f;
#pragma unroll
                    for (int bj = 0; bj < 2; ++bj)
#pragma unroll
                        for (int n = 0; n < 2; ++n) { v[bj][n] = acc[ai][bj][m][n] * rs; ss += (v[bj][n][0] * v[bj][n][0] + v[bj][n][1] * v[bj][n][1]) + (v[bj][n][2] * v[bj][n][2] + v[bj][n][3] * v[bj][n][3]); }
                    ss += __shfl_xor(ss, 16); ss += __shfl_xor(ss, 32);
                    const float r = rsqrtf(ss * (1.f / 64.f) + EPS) * sc;
#pragma unroll
                    for (int bj = 0; bj < 2; ++bj) {
                        const f32x4 a = v[bj][0] * wv[bj][0] * r, b = v[bj][1] * wv[bj][1] * r;
                        u32x4 o; o.x = pk2(a[0], a[1]); o.y = pk2(a[2], a[3]); o.z = pk2(b[0], b[1]); o.w = pk2(b[2], b[3]);
                        *(u32x4*)(P + (size_t)row * PW + u.pn * 256 + 64 * wc + 32 * bj + 8 * fq) = o;
                    }
                }
        } else if (u.pn < 14) {
#pragma unroll
            for (int ai = 0; ai < 2; ++ai)
#pragma unroll
                for (int m = 0; m < 4; ++m) {
                    const int row = row0 + ai * 128 + m * 16;
                    const float rs = rsqrtf(sumsq[row] * (1.f / 1024.f) + EPS);
#pragma unroll
                    for (int bj = 0; bj < 2; ++bj) {
                        const f32x4 a = acc[ai][bj][m][0] * rs, b = acc[ai][bj][m][1] * rs;
                        u32x4 o; o.x = pk2(a[0], a[1]); o.y = pk2(a[2], a[3]); o.z = pk2(b[0], b[1]); o.w = pk2(b[2], b[3]);
                        *(u32x4*)(P + (size_t)row * PW + u.pn * 256 + 128 * bj + 32 * wc + 8 * fq) = o;
                    }
                }
        } else {
            if (wc == 0 && fq == 0) {
                const f32x4 bi = *(const f32x4*)ib, bf = *(const f32x4*)fb;
#pragma unroll
                for (int ai = 0; ai < 2; ++ai)
#pragma unroll
                    for (int m = 0; m < 4; ++m) {
                        const int row = row0 + ai * 128 + m * 16;
                        const float rs = rsqrtf(sumsq[row] * (1.f / 1024.f) + EPS);
                        *(f32x4*)(G + (size_t)row * 8) = acc[ai][0][m][0] * rs + bi;
                        *(f32x4*)(G + (size_t)row * 8 + 4) = acc[ai][0][m][1] * rs + bf;
                    }
            }
        }
    }
};

__device__ __forceinline__ void gates_job(const bf16_t* XN, const bf16_t* WIN, const float* sumsq, const float* ib, const float* fb, float* G, LAS unsigned char* lds) {
    const int tid = tid_here(), lane = tid & 63, wave = tid >> 6, fr = lane & 15, fq = lane >> 4;
#pragma unroll
    for (int i = 0; i < 4; ++i) { const int pc = tid + 512 * i, rw = pc >> 7, ch = pc & 127;
        *(LAS u32x4*)(lds + rw * 2064 + 16 * ch) = *(const u32x4*)(WIN + (size_t)(3584 + rw) * 1024 + 8 * ch); }
    __syncthreads();
    for (int rb = blockIdx.x * 8 + wave; rb < MTOK / 16; rb += gridDim.x * 8) {
        const int row0 = rb * 16;
        const bf16_t* ap = XN + (size_t)(row0 + fr) * 1024 + 8 * fq;
        const LAS unsigned char* bp = lds + fr * 2064 + 16 * fq;
        bf16x8 af[32];
#pragma unroll
        for (int ks = 0; ks < 32; ++ks) af[ks] = *(const bf16x8*)(ap + 32 * ks);
        f32x4 acc = {0.f, 0.f, 0.f, 0.f};
#pragma unroll
        for (int ks = 0; ks < 32; ++ks) acc = __builtin_amdgcn_mfma_f32_16x16x32_bf16(af[ks], *(const LAS bf16x8*)(bp + 64 * ks), acc, 0, 0, 0);
        if (fr < 8) { const float bias = (fr < 4) ? ib[fr] : fb[fr - 4];
#pragma unroll
            for (int e = 0; e < 4; ++e) { const int row = row0 + 4 * fq + e; G[(size_t)row * 8 + fr] = acc[e] * rsqrtf(sumsq[row] * (1.f / 1024.f) + EPS) + bias; } }
    }
    __syncthreads();
}
__device__ __forceinline__ int dest_row0(int n0, int mode) {
    if (mode == 1) return 256 * (n0 / 128) + (n0 % 128);
    if (mode == 2) return 256 * (n0 / 128) + 128 + (n0 % 128);
    if (mode == 3 && n0 < 1024) { const int tile = n0 / 256, within = n0 % 256, wc = within / 64, bj = (within % 64) / 32; return 256 * tile + 128 * bj + 32 * wc; }
    return n0;
}
__device__ __forceinline__ void transpose_item(const float* W, int ldw, int nblk, int K, bf16_t* WT, int mode, LAS float* scr, int item, int lane, const float* kscale = nullptr) {
    const int kb = item / nblk, nb = item % nblk, k0 = 64 * kb, n0 = 32 * nb, d0 = dest_row0(n0, mode);
#pragma unroll 8
    for (int i = 0; i < 32; ++i) { const int kk = 2 * i + (lane >> 5); scr[kk * 33 + (lane & 31)] = W[(size_t)(k0 + kk) * ldw + n0 + (lane & 31)] * (kscale ? kscale[k0 + kk] : 1.f); }
    asm volatile("s_waitcnt lgkmcnt(0)" ::: "memory");
    const int c = lane & 7;
#pragma unroll
    for (int j = 0; j < 4; ++j) { const int n = (lane >> 3) + 8 * j; const LAS float* s = scr + (8 * c) * 33 + n;
        u32x4 o; o.x = pk2(s[0 * 33], s[1 * 33]); o.y = pk2(s[2 * 33], s[3 * 33]); o.z = pk2(s[4 * 33], s[5 * 33]); o.w = pk2(s[6 * 33], s[7 * 33]);
        *(u32x4*)(WT + (size_t)(d0 + n) * K + k0 + 8 * c) = o; }
    asm volatile("s_waitcnt lgkmcnt(0)" ::: "memory");
}
__device__ __forceinline__ void rms_row_to_bf16(const float* xrow, const float* w, bf16_t* orow, int lane) {
    const f32x4* xr = (const f32x4*)xrow + lane; const f32x4* wr_ = (const f32x4*)w + lane;
    f32x4 v[4]; float s = 0.f;
#pragma unroll
    for (int j = 0; j < 4; ++j) { v[j] = xr[64 * j]; s += (v[j][0] * v[j][0] + v[j][1] * v[j][1]) + (v[j][2] * v[j][2] + v[j][3] * v[j][3]); }
    const float rstd = rsqrtf(wave_sum(s) * (1.f / 1024.f) + EPS);
    u32x2* o8 = (u32x2*)orow + lane;
#pragma unroll
    for (int j = 0; j < 4; ++j) { const f32x4 g = wr_[64 * j]; u32x2 o; o.x = pk2(v[j][0] * rstd * g[0], v[j][1] * rstd * g[1]); o.y = pk2(v[j][2] * rstd * g[2], v[j][3] * rstd * g[3]); o8[64 * j] = o; }
}

struct Args { const float* in[20]; float* out; unsigned char* ws; };
enum { I_X = 0, I_N1, I_G1, I_U1, I_D1, I_NM, I_WIN, I_QNW, I_KNW, I_CW, I_CB, I_IB, I_FB, I_AG, I_MG, I_WO, I_N2, I_G2, I_U2, I_D2 };

__device__ __forceinline__ void prologue(const Args& a, LAS unsigned char* lds) {
    const int tid = tid_here(), lane = tid & 63, wave = tid >> 6, G = gridDim.x;
    const int gw = blockIdx.x * 8 + wave, NGW = G * 8; const int gt = blockIdx.x * 512 + tid, NGT = G * 512;
    unsigned char* ws = a.ws;
    for (int i = gt; i < 2 * MTOK; i += NGT) ((float*)(ws + WS_SS2))[i] = 0.f;
    { bf16_t* WIN = (bf16_t*)(ws + WS_WIN); const float* W = a.in[I_WIN];
      for (int i = gt; i < 8 * 1024; i += NGT) { const int j = i >> 10, k = i & 1023; WIN[(size_t)(3584 + j) * 1024 + k] = f2bf1(W[(size_t)k * DIN + 3584 + j] * a.in[I_NM][k]); }
      for (int i = gt; i < 248 * 1024 / 8; i += NGT) ((u32x4*)(WIN + (size_t)3592 * 1024))[i] = (u32x4){0u, 0u, 0u, 0u}; }
    LAS float* scr = (LAS float*)(lds + wave * 16384);
    constexpr int I_GU = 16 * 88, I_DN = 44 * 32, I_IN = 16 * 112, I_OUT = 16 * 32;
    constexpr int NITEMS = 4 * I_GU + 2 * I_DN + I_IN + I_OUT;
    for (int it = gw; it < NITEMS; it += NGW) {
        int r = it;
        if (r < I_GU) { transpose_item(a.in[I_G1], DFF, 88, 1024, (bf16_t*)(ws + WS_WG1), 1, scr, r, lane); continue; } r -= I_GU;
        if (r < I_GU) { transpose_item(a.in[I_U1], DFF, 88, 1024, (bf16_t*)(ws + WS_WG1), 2, scr, r, lane); continue; } r -= I_GU;
        if (r < I_GU) { transpose_item(a.in[I_G2], DFF, 88, 1024, (bf16_t*)(ws + WS_WG2), 1, scr, r, lane, a.in[I_N2]); continue; } r -= I_GU;
        if (r < I_GU) { transpose_item(a.in[I_U2], DFF, 88, 1024, (bf16_t*)(ws + WS_WG2), 2, scr, r, lane, a.in[I_N2]); continue; } r -= I_GU;
        if (r < I_DN) { transpose_item(a.in[I_D1], DM, 32, DFF, (bf16_t*)(ws + WS_WD1), 0, scr, r, lane); continue; } r -= I_DN;
        if (r < I_DN) { transpose_item(a.in[I_D2], DM, 32, DFF, (bf16_t*)(ws + WS_WD2), 0, scr, r, lane); continue; } r -= I_DN;
        if (r < I_IN) { transpose_item(a.in[I_WIN], DIN, 112, 1024, (bf16_t*)(ws + WS_WIN), 3, scr, r, lane, a.in[I_NM]); continue; } r -= I_IN;
        transpose_item(a.in[I_WO], DM, 32, 1024, (bf16_t*)(ws + WS_WOUT), 0, scr, r, lane);
    }
    {
        const f32x4* wr_ = (const f32x4*)a.in[I_N1] + lane; f32x4 g[4];
#pragma unroll
        for (int j = 0; j < 4; ++j) g[j] = wr_[64 * j];
        for (int m = gw; m < MTOK; m += 2 * NGW) {
            const int m2 = m + NGW; const bool has2 = m2 < MTOK;
            const f32x4* xa = (const f32x4*)(a.in[I_X] + (size_t)m * DM) + lane; const f32x4* xb = (const f32x4*)(a.in[I_X] + (size_t)(has2 ? m2 : m) * DM) + lane;
            f32x4 va[4], vb[4]; float sa = 0.f, sb = 0.f;
#pragma unroll
            for (int j = 0; j < 4; ++j) { va[j] = xa[64 * j]; vb[j] = xb[64 * j]; }
#pragma unroll
            for (int j = 0; j < 4; ++j) { sa += (va[j][0] * va[j][0] + va[j][1] * va[j][1]) + (va[j][2] * va[j][2] + va[j][3] * va[j][3]); sb += (vb[j][0] * vb[j][0] + vb[j][1] * vb[j][1]) + (vb[j][2] * vb[j][2] + vb[j][3] * vb[j][3]); }
            const float ra = rsqrtf(wave_sum(sa) * (1.f / 1024.f) + EPS), rb = rsqrtf(wave_sum(sb) * (1.f / 1024.f) + EPS);
            u32x2* oa = (u32x2*)((bf16_t*)(ws + WS_XN) + (size_t)m * DM) + lane; u32x2* ob = (u32x2*)((bf16_t*)(ws + WS_XN) + (size_t)m2 * DM) + lane;
#pragma unroll
            for (int j = 0; j < 4; ++j) { u32x2 o; o.x = pk2(va[j][0] * ra * g[j][0], va[j][1] * ra * g[j][1]); o.y = pk2(va[j][2] * ra * g[j][2], va[j][3] * ra * g[j][3]); oa[64 * j] = o; }
            if (has2) {
#pragma unroll
                for (int j = 0; j < 4; ++j) { u32x2 o; o.x = pk2(vb[j][0] * rb * g[j][0], vb[j][1] * rb * g[j][1]); o.y = pk2(vb[j][2] * rb * g[j][2], vb[j][3] * rb * g[j][3]); ob[64 * j] = o; } }
        }
    }
}

__device__ __forceinline__ void attn_naive(const bf16_t* P, const float* gain, bf16_t* Y) {
    for (int idx = blockIdx.x * 512 + threadIdx.x; idx < 8 * MTOK; idx += gridDim.x * 512) {
        const int h = idx >> 15, row = idx & (MTOK - 1), t = row & (SEQL - 1);
        float q[64], o[64]; float l = 0.f;
        { const bf16_t* qp = P + (size_t)row * PW + PC_QA + h * 64;
#pragma unroll
          for (int c = 0; c < 8; ++c) { const u32x4 w = *(const u32x4*)(qp + 8 * c);
#pragma unroll
            for (int e = 0; e < 4; ++e) { q[8 * c + 2 * e] = __uint_as_float(w[e] << 16); q[8 * c + 2 * e + 1] = __uint_as_float(w[e] & 0xffff0000u); } } }
#pragma unroll
        for (int d = 0; d < 64; ++d) o[d] = 0.f;
        const float slope = exp2f(-(float)(h + 1)) * LOG2E;
        for (int g = 0; g < 3; ++g) {
            const int dil = (g == 0) ? 1 : (g == 1) ? 4 : 16;
            for (int j = 0; j <= 128; ++j) {
                const int dist = j * dil; if (dist > t) break;
                const bf16_t* kp = P + (size_t)(row - dist) * PW + PC_KA + h * 64; const bf16_t* vp = kp + (PC_VA - PC_KA);
                float s = 0.f;
#pragma unroll
                for (int c = 0; c < 8; ++c) { const u32x4 w = *(const u32x4*)(kp + 8 * c);
#pragma unroll
                    for (int e = 0; e < 4; ++e) { s += q[8 * c + 2 * e] * __uint_as_float(w[e] << 16); s += q[8 * c + 2 * e + 1] * __uint_as_float(w[e] & 0xffff0000u); } }
                const float p = exp2f(s - slope * (float)dist); l += p;
#pragma unroll
                for (int c = 0; c < 8; ++c) { const u32x4 w = *(const u32x4*)(vp + 8 * c);
#pragma unroll
                    for (int e = 0; e < 4; ++e) { o[8 * c + 2 * e] += p * __uint_as_float(w[e] << 16); o[8 * c + 2 * e + 1] += p * __uint_as_float(w[e] & 0xffff0000u); } }
            }
        }
        const float inv = 1.f / l; float ss = 0.f;
#pragma unroll
        for (int d = 0; d < 64; ++d) { o[d] *= inv; ss += o[d] * o[d]; }
        const float r = rsqrtf(ss * (1.f / 64.f) + EPS);
        bf16_t* yp = Y + (size_t)row * DM + h * 64; const float* gp = gain + h * 64;
#pragma unroll
        for (int c = 0; c < 8; ++c) { u32x4 w;
#pragma unroll
            for (int e = 0; e < 4; ++e) w[e] = pk2(o[8 * c + 2 * e] * r * gp[8 * c + 2 * e], o[8 * c + 2 * e + 1] * r * gp[8 * c + 2 * e + 1]);
            *(u32x4*)(yp + 8 * c) = w; }
    }
}
__device__ __forceinline__ void mlstm_naive(const bf16_t* P, const float* Gt, const float* cw, const float* cb, const float* gain, bf16_t* Y, LAS float* sm) {
    LAS float* qs = sm; LAS float* ks = sm + 128; LAS float* part = sm + 256; LAS float* red = sm + 768;
    const int tid = threadIdx.x, lane = tid & 63, e = tid & 127, g = tid >> 7;
    for (int st = blockIdx.x; st < 64; st += gridDim.x) {
        const int b = st >> 2, h = st & 3;
        float C[32]; float nn = 0.f;
#pragma unroll
        for (int d = 0; d < 32; ++d) C[d] = 0.f;
        for (int t = 0; t < SEQL; ++t) {
            const int row = b * SEQL + t;
            if (tid < 256) {
                const int which = tid >> 7, ch = h * 128 + (tid & 127), c = which * 512 + ch;
                float acc = cb[c];
#pragma unroll
                for (int j = 0; j < 4; ++j) { const int tt = t - 3 + j; if (tt >= 0) acc += cw[j * 1024 + c] * bf2f(P[(size_t)(row - 3 + j) * PW + PC_QM + which * 512 + ch]); }
                float val = silu_f(acc); if (which) val *= 0.08838834764831845f;
                (which ? ks : qs)[tid & 127] = val;
            }
            __syncthreads();
            const float ig = __expf(Gt[(size_t)row * 8 + h]), fg = sigmoid_f(Gt[(size_t)row * 8 + 4 + h]);
            const float ve = bf2f(P[(size_t)row * PW + PC_VM + h * 128 + e]);
            float pn = 0.f;
#pragma unroll
            for (int d = 0; d < 32; ++d) { const int dk = g * 32 + d; C[d] = fg * C[d] + ig * ks[dk] * ve; pn += qs[dk] * C[d]; }
            part[g * 128 + e] = pn;
            if (tid < 128) { nn = fg * nn + ig * ks[tid]; const float qn = wave_sum(qs[tid] * nn); if (lane == 0) red[tid >> 6] = qn; }
            __syncthreads();
            float hval = 0.f;
            if (tid < 128) {
                const float num = (part[e] + part[128 + e]) + (part[256 + e] + part[384 + e]);
                const float den = red[0] + red[1];
                hval = num / fmaxf(fabsf(den), 1.f);
                hval *= sigmoid_f(bf2f(P[(size_t)row * PW + PC_OM + h * 128 + e]));
                const float ss = wave_sum(hval * hval); if (lane == 0) red[2 + (tid >> 6)] = ss;
            }
            __syncthreads();
            if (tid < 128) { const float r = rsqrtf((red[2] + red[3]) * (1.f / 128.f) + EPS); Y[(size_t)row * DM + 512 + h * 128 + e] = f2bf1(hval * r * gain[h * 128 + e]); }
        }
    }
}
#define XB_TMO      128
#define XB_XCNT(j)  (256  + 64 * (j))
#define XB_XSUB(j)  (1280 + 64 * (j))
#define XB_XGEN(j)  (2304 + 64 * (j))
#define XB_TOP      3328
#define XB_TOPGEN   3392
#define XCD_BAR_WORDS 3456
#define XB_SPIN_CAP (1u << 18)

__device__ __forceinline__ unsigned xb_ld(unsigned* p)              { return __hip_atomic_load(p, __ATOMIC_RELAXED, __HIP_MEMORY_SCOPE_AGENT); }
__device__ __forceinline__ unsigned xb_add(unsigned* p, unsigned v) { return __hip_atomic_fetch_add(p, v, __ATOMIC_RELAXED, __HIP_MEMORY_SCOPE_AGENT); }
__device__ __forceinline__ unsigned xb_xcc_id() { return (unsigned)__builtin_amdgcn_s_getreg((3 << 11) | 20) & 0xFu; }
#define XB_SPIN(cond, bar) do { unsigned _sp = 0; while (cond) { __builtin_amdgcn_s_sleep(1); \
    if ((++_sp & 255u) == 0u) { if (xb_ld(&(bar)[XB_TMO])) break; if (_sp > XB_SPIN_CAP) { atomicAdd(&(bar)[XB_TMO], 1u); break; } } } } while (0)

struct XcdBarrier {
    unsigned* bar; unsigned x;
    volatile LAS unsigned* st;
};

__device__ __forceinline__ XcdBarrier xcd_barrier_post(unsigned* bar, volatile LAS unsigned* st) {
    XcdBarrier b; b.bar = bar; b.x = xb_xcc_id(); b.st = st;
    if (threadIdx.x == 0) (void)xb_add(&bar[XB_XCNT(b.x)], 1u);
    return b;
}
__device__ __forceinline__ void xcd_barrier_complete(unsigned* bar, unsigned x, unsigned& nloc, unsigned& nx) {
    const unsigned G = gridDim.x * gridDim.y * gridDim.z;
    unsigned sum, cnt, mine, sp = 0u;
    for (;;) {
        sum = 0u; cnt = 0u; mine = 0u;
#pragma unroll
        for (unsigned j = 0; j < 16; ++j) { const unsigned c = xb_ld(&bar[XB_XCNT(j)]); sum += c; cnt += (c > 0u) ? 1u : 0u; mine = (j == x) ? c : mine; }
        if (sum == G) break;
        __builtin_amdgcn_s_sleep(1);
        if ((++sp & 255u) == 0u) { if (xb_ld(&bar[XB_TMO])) break; if (sp > XB_SPIN_CAP) { atomicAdd(&bar[XB_TMO], 1u); break; } }
    }
    nloc = mine > 0u ? mine : 1u; nx = cnt > 0u ? cnt : 1u;
}

__device__ __forceinline__ void xcd_barrier(const XcdBarrier& b) {
    asm volatile("s_waitcnt vmcnt(0)" ::: "memory");
    __syncthreads();
    if (threadIdx.x == 0) {
        unsigned* bar = b.bar;
        __builtin_amdgcn_s_waitcnt(0);
        unsigned nloc = b.st[0], nx = b.st[1];
        if (nloc == 0u) { xcd_barrier_complete(bar, b.x, nloc, nx); b.st[0] = nloc; b.st[1] = nx; }
        const unsigned old = xb_add(&bar[XB_XSUB(b.x)], 1u);
        const unsigned gen = old / nloc;
        if (old + 1u == (gen + 1u) * nloc) {
            __builtin_amdgcn_fence(__ATOMIC_RELEASE, "agent");
            asm volatile("s_waitcnt vmcnt(0)" ::: "memory");
            const unsigned og = xb_add(&bar[XB_TOP], 1u);
            const unsigned tg = og / nx;
            if (og + 1u == (tg + 1u) * nx) xb_add(&bar[XB_TOPGEN], 1u);
            else XB_SPIN(xb_ld(&bar[XB_TOPGEN]) == tg, bar);
            __builtin_amdgcn_fence(__ATOMIC_ACQUIRE, "agent");
            xb_add(&bar[XB_XGEN(b.x)], 1u);
            asm volatile("s_waitcnt vmcnt(0)" ::: "memory");
        } else {
            XB_SPIN(xb_ld(&bar[XB_XGEN(b.x)]) == gen, bar);
            __builtin_amdgcn_fence(__ATOMIC_ACQUIRE, "agent");
            asm volatile("s_waitcnt vmcnt(0)" ::: "memory");
        }
    }
    __syncthreads();
}

typedef float f32x16 __attribute__((ext_vector_type(16)));
typedef short v4i16_t __attribute__((ext_vector_type(4)));
#define MFMA32(a, b, c) __builtin_amdgcn_mfma_f32_32x32x16_bf16((a), (b), (c), 0, 0, 0)
__device__ __forceinline__ int crow(int i, int h) { return (i & 3) + 8 * (i >> 2) + 4 * h; }
__device__ __forceinline__ bf16x8 tr2(const LAS unsigned char* p0, const LAS unsigned char* p1) {
    const v4i16_t lo = __builtin_amdgcn_ds_read_tr16_b64_v4i16((LAS v4i16_t*)p0), hi = __builtin_amdgcn_ds_read_tr16_b64_v4i16((LAS v4i16_t*)p1);
    return (bf16x8){lo[0], lo[1], lo[2], lo[3], hi[0], hi[1], hi[2], hi[3]};
}
__device__ __forceinline__ bf16x8 ld2x8(const bf16_t* p0, const bf16_t* p1) {
    const u32x2 a = *(const u32x2*)p0, b = *(const u32x2*)p1; const u32x4 w = {a.x, a.y, b.x, b.y}; return __builtin_bit_cast(bf16x8, w);
}
__device__ __forceinline__ bf16x8 lds2x8(const LAS unsigned char* p0, const LAS unsigned char* p1) {
    const u32x2 a = *(const LAS u32x2*)p0, b = *(const LAS u32x2*)p1; const u32x4 w = {a.x, a.y, b.x, b.y}; return __builtin_bit_cast(bf16x8, w);
}
#define PACK8(v, base) __builtin_bit_cast(bf16x8, (u32x4){pk2((v)[(base)], (v)[(base) + 1]), pk2((v)[(base) + 2], (v)[(base) + 3]), pk2((v)[(base) + 4], (v)[(base) + 5]), pk2((v)[(base) + 6], (v)[(base) + 7])})
#define LFENCE() asm volatile("" ::: "memory")

constexpr int VROW = 144;
template <int MODE>
__device__ __forceinline__ void attn_task(const bf16_t* PR, int b, int head, int res, int dil, int qt, LAS unsigned char* vl, bf16_t* Po, float* Lo,
                                          const bf16_t* P4, const bf16_t* P16, const float* L4, const float* L16, const float* gain, bf16_t* Y, int lane) {
    const int r = lane & 31, h = lane >> 5, li = lane & 15, gg = (lane >> 4) & 1;
    const size_t seqrow0 = (size_t)b * SEQL + res;
    const int q0 = 32 * qt;
    const size_t rstride = (size_t)dil * PW;
    bf16x8 qf[4];
    { const bf16_t* qp = PR + (seqrow0 + (size_t)(q0 + r) * dil) * PW + PC_QA + head * 64 + 8 * h;
#pragma unroll
      for (int s = 0; s < 4; ++s) qf[s] = *(const bf16x8*)(qp + 16 * s); }
    f32x16 o[2];
#pragma unroll
    for (int dt = 0; dt < 2; ++dt)
#pragma unroll
        for (int i = 0; i < 16; ++i) o[dt][i] = 0.f;
    float l = 0.f;
    const float slope = exp2f(-(float)(head + 1)) * LOG2E * (float)dil;
    const LAS unsigned char* trb = vl + (4 * h + (li >> 2)) * VROW + (16 * gg + 4 * (li & 3)) * 2;
    const int first = (q0 >= 128) ? 0 : ((128 - q0) >> 5);
    const size_t prow = (seqrow0 + (size_t)(q0 - 128 + 32 * first + (lane >> 3)) * dil) * PW + head * 64 + 8 * (lane & 7);
    const bf16_t* kp = PR + prow + PC_KA; const bf16_t* vp = PR + prow + PC_VA;
    LAS unsigned char* kl = vl + 4608;
    const int stoff = (lane >> 3) * VROW + 16 * (lane & 7);
    u32x4 kn[4], vn[4];
#pragma unroll
    for (int i = 0; i < 4; ++i) { kn[i] = *(const u32x4*)(kp + (size_t)(8 * i) * rstride); vn[i] = *(const u32x4*)(vp + (size_t)(8 * i) * rstride); }
    const int rr = r - 4 * h;
#pragma unroll 1
    for (int kt = first; kt < 5; ++kt) {
#pragma unroll
        for (int i = 0; i < 4; ++i) { *(LAS u32x4*)(kl + stoff + 8 * i * VROW) = kn[i]; *(LAS u32x4*)(vl + stoff + 8 * i * VROW) = vn[i]; }
        LFENCE();
        if (kt < 4) {
            kp += 32 * rstride; vp += 32 * rstride;
#pragma unroll
            for (int i = 0; i < 4; ++i) { kn[i] = *(const u32x4*)(kp + (size_t)(8 * i) * rstride); vn[i] = *(const u32x4*)(vp + (size_t)(8 * i) * rstride); }
        }
        const float fb = slope * (float)(rr + 128 - 32 * kt);
        f32x16 s;
#pragma unroll
        for (int i = 0; i < 16; ++i) s[i] = slope * (float)((i & 3) + 8 * (i >> 2)) - fb;
#pragma unroll
        for (int ks = 0; ks < 4; ++ks) s = MFMA32(*(const LAS bf16x8*)(kl + r * VROW + 32 * ks + 16 * h), qf[ks], s);
        if (kt == 0 || kt == 4) {
#pragma unroll
            for (int i = 0; i < 16; ++i) { const int c = (i & 3) + 8 * (i >> 2); const bool ok = (kt == 4) ? (c <= rr) : (c >= rr); s[i] = ok ? s[i] : -__builtin_inff(); }
        }
        float ls = 0.f;
#pragma unroll
        for (int i = 0; i < 16; ++i) { const float p = __builtin_amdgcn_exp2f(s[i]); s[i] = p; ls += p; }
        l += ls;
        const bf16x8 pf0 = PACK8(s, 0), pf1 = PACK8(s, 8);
#pragma unroll
        for (int dt = 0; dt < 2; ++dt) { const bf16x8 v0 = tr2(trb + 64 * dt, trb + 8 * VROW + 64 * dt), v1 = tr2(trb + 16 * VROW + 64 * dt, trb + 24 * VROW + 64 * dt);
            o[dt] = MFMA32(v0, pf0, o[dt]); o[dt] = MFMA32(v1, pf1, o[dt]); }
        LFENCE();
    }
    {
        const float lt0 = l + __shfl_xor(l, 32);
        const size_t row = seqrow0 + (size_t)(q0 + r) * dil;
        if (MODE == 0) {
#pragma unroll
            for (int dt = 0; dt < 2; ++dt)
#pragma unroll
                for (int ii = 0; ii < 4; ++ii) { u32x2 w; w.x = pk2(o[dt][4 * ii], o[dt][4 * ii + 1]); w.y = pk2(o[dt][4 * ii + 2], o[dt][4 * ii + 3]);
                    *(u32x2*)(Po + row * 512 + head * 64 + 32 * dt + 8 * ii + 4 * h) = w; }
            if (h == 0) Lo[row * 8 + head] = lt0;
        } else {
            const float lt = lt0 + L4[row * 8 + head] + L16[row * 8 + head]; const float inv = 1.f / lt; float ss = 0.f;
#pragma unroll
            for (int dt = 0; dt < 2; ++dt)
#pragma unroll
                for (int ii = 0; ii < 4; ++ii) { const size_t off = row * 512 + head * 64 + 32 * dt + 8 * ii + 4 * h;
                    const u32x2 a = *(const u32x2*)(P4 + off), c = *(const u32x2*)(P16 + off);
                    const float add[4] = {__uint_as_float(a.x << 16) + __uint_as_float(c.x << 16), __uint_as_float(a.x & 0xffff0000u) + __uint_as_float(c.x & 0xffff0000u),
                                          __uint_as_float(a.y << 16) + __uint_as_float(c.y << 16), __uint_as_float(a.y & 0xffff0000u) + __uint_as_float(c.y & 0xffff0000u)};
#pragma unroll
                    for (int e = 0; e < 4; ++e) { const float v = (o[dt][4 * ii + e] + add[e]) * inv; o[dt][4 * ii + e] = v; ss += v * v; } }
            ss += __shfl_xor(ss, 32);
            const float rr = rsqrtf(ss * (1.f / 64.f) + EPS);
#pragma unroll
            for (int dt = 0; dt < 2; ++dt)
#pragma unroll
                for (int ii = 0; ii < 4; ++ii) { const int d0 = head * 64 + 32 * dt + 8 * ii + 4 * h; const f32x4 gv = *(const f32x4*)(gain + d0);
                    u32x2 w; w.x = pk2(o[dt][4 * ii] * rr * gv[0], o[dt][4 * ii + 1] * rr * gv[1]); w.y = pk2(o[dt][4 * ii + 2] * rr * gv[2], o[dt][4 * ii + 3] * rr * gv[3]);
                    *(u32x2*)(Y + row * DM + d0) = w; }
        }
    }
}

__device__ __forceinline__ void conv_local(const bf16_t* PR, const float* cw, const float* cb, bf16_t* QC, bf16_t* KC, int st) {
    const int tid = tid_here(), oct = tid & 31, rrange = tid >> 5;
    const int b = st >> 4, hm = (st >> 2) & 3, seg = st & 3;
    const int c8 = (oct < 16) ? (hm * 128 + oct * 8) : (512 + hm * 128 + (oct - 16) * 8);
    float wgt[4][8], bias[8];
#pragma unroll
    for (int j = 0; j < 4; ++j) { const f32x4 w0 = *(const f32x4*)(cw + j * 1024 + c8), w1 = *(const f32x4*)(cw + j * 1024 + c8 + 4);
#pragma unroll
        for (int e = 0; e < 4; ++e) { wgt[j][e] = w0[e]; wgt[j][4 + e] = w1[e]; } }
    { const f32x4 b0 = *(const f32x4*)(cb + c8), b1 = *(const f32x4*)(cb + c8 + 4);
#pragma unroll
      for (int e = 0; e < 4; ++e) { bias[e] = b0[e]; bias[4 + e] = b1[e]; } }
    const float sc = (c8 >= 512) ? 0.08838834764831845f : 1.f;
    bf16_t* dst0 = (c8 >= 512) ? (KC + (c8 - 512)) : (QC + c8);
    {
        const int R0 = b * SEQL + seg * 512 + rrange * 32; const bool first = (R0 & (SEQL - 1)) == 0;
        float x1[8], x2[8], x3[8];
        { const bf16_t* src = PR + (size_t)R0 * PW + PC_QM + c8;
          u32x4 a1 = {0u, 0u, 0u, 0u}, a2 = a1, a3 = a1;
          if (!first) { a1 = *(const u32x4*)(src - PW); a2 = *(const u32x4*)(src - 2 * PW); a3 = *(const u32x4*)(src - 3 * PW); }
#pragma unroll
          for (int e = 0; e < 4; ++e) { x1[2 * e] = __uint_as_float(a1[e] << 16); x1[2 * e + 1] = __uint_as_float(a1[e] & 0xffff0000u);
              x2[2 * e] = __uint_as_float(a2[e] << 16); x2[2 * e + 1] = __uint_as_float(a2[e] & 0xffff0000u);
              x3[2 * e] = __uint_as_float(a3[e] << 16); x3[2 * e + 1] = __uint_as_float(a3[e] & 0xffff0000u); } }
#pragma unroll 4
        for (int i = 0; i < 32; ++i) {
            const u32x4 xv = *(const u32x4*)(PR + (size_t)(R0 + i) * PW + PC_QM + c8);
            float x0[8];
#pragma unroll
            for (int e = 0; e < 4; ++e) { x0[2 * e] = __uint_as_float(xv[e] << 16); x0[2 * e + 1] = __uint_as_float(xv[e] & 0xffff0000u); }
            u32x4 o;
#pragma unroll
            for (int e = 0; e < 4; ++e) {
                const float v0 = bias[2 * e] + wgt[0][2 * e] * x3[2 * e] + wgt[1][2 * e] * x2[2 * e] + wgt[2][2 * e] * x1[2 * e] + wgt[3][2 * e] * x0[2 * e];
                const float v1 = bias[2 * e + 1] + wgt[0][2 * e + 1] * x3[2 * e + 1] + wgt[1][2 * e + 1] * x2[2 * e + 1] + wgt[2][2 * e + 1] * x1[2 * e + 1] + wgt[3][2 * e + 1] * x0[2 * e + 1];
                o[e] = pk2(silu_f(v0) * sc, silu_f(v1) * sc); }
            *(u32x4*)(dst0 + (size_t)(R0 + i) * 512) = o;
#pragma unroll
            for (int e = 0; e < 8; ++e) { x3[e] = x2[e]; x2[e] = x1[e]; x1[e] = x0[e]; }
        }
    }
}

constexpr int KROW = 272, OROW = 80;
constexpr int ML_PARK = 65536, ML_QT = 106496;
constexpr int ML_KT = 0, ML_VT = 64 * KROW, ML_VW = 2 * 64 * KROW, ML_ONE_T = 3 * 64 * KROW, ML_ONE_W = ML_ONE_T + 64 * OROW, ML_TAB = ML_ONE_W + 64 * OROW;
__device__ __forceinline__ void ml_final1(f32x16 (&res)[2], const bf16_t* PR, size_t r0, int hm, int w, int r, int h, const LAS float* den_t, LAS float* ssq_t) {
#pragma unroll
    for (int tt = 0; tt < 2; ++tt) {
        const float dd = 1.f / fmaxf(fabsf(den_t[32 * tt + r]), 1.f); float ss = 0.f;
        const bf16_t* op = PR + (r0 + 32 * tt + r) * PW + PC_OM + hm * 128 + 32 * w + 4 * h;
#pragma unroll
        for (int g4 = 0; g4 < 4; ++g4) { const u32x2 ov = *(const u32x2*)(op + 8 * g4);
            const float og[4] = {__uint_as_float(ov.x << 16), __uint_as_float(ov.x & 0xffff0000u), __uint_as_float(ov.y << 16), __uint_as_float(ov.y & 0xffff0000u)};
#pragma unroll
            for (int e = 0; e < 4; ++e) { const float v = res[tt][4 * g4 + e] * dd * sigmoid_f(og[e]); res[tt][4 * g4 + e] = v; ss += v * v; } }
        ss += __shfl_xor(ss, 32);
        if (h == 0) ssq_t[64 * w + 32 * tt + r] = ss;
    }
}
__device__ __forceinline__ void ml_final2(const f32x16 (&res)[2], const float* gain, bf16_t* Y, size_t r0, int hm, int w, int r, int h, const LAS float* ssq_t) {
#pragma unroll
    for (int tt = 0; tt < 2; ++tt) {
        const int t = 32 * tt + r;
        const float rr = rsqrtf(((ssq_t[t] + ssq_t[64 + t]) + (ssq_t[128 + t] + ssq_t[192 + t])) * (1.f / 128.f) + EPS);
#pragma unroll
        for (int g4 = 0; g4 < 4; ++g4) { const int d0 = hm * 128 + 32 * w + 8 * g4 + 4 * h; const f32x4 gv = *(const f32x4*)(gain + d0);
            u32x2 o; o.x = pk2(res[tt][4 * g4] * rr * gv[0], res[tt][4 * g4 + 1] * rr * gv[1]); o.y = pk2(res[tt][4 * g4 + 2] * rr * gv[2], res[tt][4 * g4 + 3] * rr * gv[3]);
            *(u32x2*)(Y + (r0 + t) * DM + 512 + d0) = o; }
    }
}
__device__ __forceinline__ float* num_ptr(float* NB, size_t token, int hm) { return NB + token * 512 + hm * 128; }

__device__ __forceinline__ void mlstm_pass1(const bf16_t* PR, const bf16_t* QC, const bf16_t* KC, const float* Gt, const float* gain, bf16_t* Y, LAS unsigned char* lds,
                                            float* NB, float* DEN, float* BC, float* FIMG, float* DSEG, int st_first, int st_stride) {
    const int tid = tid_here(), lane = tid & 63, w = __builtin_amdgcn_readfirstlane(tid >> 6);
    const int r = lane & 31, h = lane >> 5, li = lane & 15, gg = (lane >> 4) & 1;
    LAS float* cs_t = (LAS float*)(lds + ML_TAB); LAS float* den_t = cs_t + 64; LAS float* ssq_t = cs_t + 128;
    for (int st = st_first; st < 256; st += st_stride) {
        const int b = st >> 4, hm = (st >> 2) & 3, seg = st & 3;
        __syncthreads();
        for (int i = tid; i < 64 * OROW / 4; i += 512) { ((LAS unsigned*)(lds + ML_ONE_T))[i] = ((i % (OROW / 4)) == 0) ? 0x00003f80u : 0u; ((LAS unsigned*)(lds + ML_ONE_W))[i] = 0u; }
        __syncthreads();
        f32x16 C[4];
#pragma unroll
        for (int i = 0; i < 4; ++i)
#pragma unroll
            for (int e = 0; e < 16; ++e) C[i][e] = 0.f;
        const LAS unsigned char* vtb = (w < 4) ? (lds + ML_VT + 64 * w) : (lds + ML_ONE_T);
        const LAS unsigned char* vwb = (w < 4) ? (lds + ML_VW + 64 * w) : (lds + ML_ONE_W);
        const int vstr = (w < 4) ? KROW : OROW;
        float Bseg = 0.f;
        const int frow = tid >> 4, fch = tid & 15;
        const size_t rs0 = (size_t)b * SEQL + 64 * (8 * seg);
        const bf16_t* pK = KC + (rs0 + frow) * 512 + hm * 128 + 8 * fch; const bf16_t* pQ = QC + (rs0 + frow) * 512 + hm * 128 + 8 * fch;
        const bf16_t* pV = PR + (rs0 + frow) * PW + PC_VM + hm * 128 + 8 * fch; const float* pG = Gt + (rs0 + lane) * 8 + hm;
        u32x4 fK[2], fV[2], fQ[2]; float f_ip, f_fp;
#pragma unroll
        for (int p = 0; p < 2; ++p) { fK[p] = *(const u32x4*)(pK + (size_t)32 * p * 512); fQ[p] = *(const u32x4*)(pQ + (size_t)32 * p * 512); fV[p] = *(const u32x4*)(pV + (size_t)32 * p * PW); }
        f_ip = pG[0]; f_fp = pG[4];
        for (int cc = 0; cc < 8; ++cc) {
            const size_t r0 = rs0 + 64 * cc;
            const float ip = f_ip, fp = f_fp;
            const float lf = -__logf(1.f + __expf(-fp));
            const float bsum = wave_incl_scan(lf);
            const float bL = __int_as_float(__builtin_amdgcn_readlane(__float_as_int(bsum), 63)), csv = ip - bsum, wgt = __expf(bL + csv), decay = __expf(bL);
#pragma unroll
            for (int p = 0; p < 2; ++p) { const int row = frow + 32 * p;
                const float wr_ = __shfl(wgt, row);
                u32x4 vw;
#pragma unroll
                for (int e = 0; e < 4; ++e) vw[e] = pk2(__uint_as_float(fV[p][e] << 16) * wr_, __uint_as_float(fV[p][e] & 0xffff0000u) * wr_);
                *(LAS u32x4*)(lds + ML_KT + row * KROW + 16 * fch) = fK[p]; *(LAS u32x4*)(lds + ML_VT + row * KROW + 16 * fch) = fV[p];
                *(LAS u32x4*)(lds + ML_VW + row * KROW + 16 * fch) = vw; *(LAS u32x4*)(lds + ML_QT + row * KROW + 16 * fch) = fQ[p]; }
            if (w == 0) { cs_t[lane] = csv; *(LAS unsigned short*)(lds + ML_ONE_W + lane * OROW) = f2bf1(wgt); }
            if (cc < 7) {
                pK += 64 * 512; pQ += 64 * 512; pV += (size_t)64 * PW; pG += 64 * 8;
#pragma unroll
                for (int p = 0; p < 2; ++p) { fK[p] = *(const u32x4*)(pK + (size_t)32 * p * 512); fQ[p] = *(const u32x4*)(pQ + (size_t)32 * p * 512); fV[p] = *(const u32x4*)(pV + (size_t)32 * p * PW); }
                f_ip = pG[0]; f_fp = pG[4];
            }
            __syncthreads();
            if (w < 5) {
#pragma unroll 1
                for (int tt = 0; tt < 2; ++tt) {
                    const LAS unsigned char* qb0 = lds + ML_QT + (32 * tt + r) * KROW + 8 * h;
                    f32x16 hi_, ha, S0, S1;
#pragma unroll
                    for (int e = 0; e < 16; ++e) { hi_[e] = 0.f; ha[e] = 0.f; S0[e] = 0.f; S1[e] = 0.f; }
                    const LAS unsigned char* kb0 = lds + ML_KT + r * KROW + 8 * h;
#pragma unroll
                    for (int i = 0; i < 4; ++i)
#pragma unroll
                        for (int s = 0; s < 2; ++s) {
                            const bf16x8 q = lds2x8(qb0 + 64 * i + 32 * s, qb0 + 64 * i + 32 * s + 16);
                            hi_ = MFMA32(PACK8(C[i], 8 * s), q, hi_);
                            S0 = MFMA32(lds2x8(kb0 + 64 * i + 32 * s, kb0 + 64 * i + 32 * s + 16), q, S0);
                            S1 = MFMA32(lds2x8(kb0 + 32 * KROW + 64 * i + 32 * s, kb0 + 32 * KROW + 64 * i + 32 * s + 16), q, S1);
                            if (s == 1) LFENCE();
                        }
                    const float bt = __shfl(bsum, 32 * tt + r);
                    const LAS unsigned char* vb = vtb + (4 * h + (li >> 2)) * vstr + (16 * gg + 4 * (li & 3)) * 2;
                    {
#pragma unroll
                        for (int g4 = 0; g4 < 4; ++g4) { const f32x4 cv = *(const LAS f32x4*)(cs_t + 8 * g4 + 4 * h);
#pragma unroll
                            for (int e = 0; e < 4; ++e) { const int sl = 8 * g4 + 4 * h + e; const bool ok = (tt == 1) || (sl <= r);
                                S0[4 * g4 + e] = ok ? S0[4 * g4 + e] * __builtin_amdgcn_exp2f((bt + cv[e]) * LOG2E) : 0.f; } }
                        ha = MFMA32(tr2(vb, vb + 8 * vstr), PACK8(S0, 0), ha);
                        ha = MFMA32(tr2(vb + 16 * vstr, vb + 24 * vstr), PACK8(S0, 8), ha);
                    }
                    if (tt == 1) {
#pragma unroll
                        for (int g4 = 0; g4 < 4; ++g4) { const f32x4 cv = *(const LAS f32x4*)(cs_t + 32 + 8 * g4 + 4 * h);
#pragma unroll
                            for (int e = 0; e < 4; ++e) { const int sl = 8 * g4 + 4 * h + e; const bool ok = (sl <= r);
                                S1[4 * g4 + e] = ok ? S1[4 * g4 + e] * __builtin_amdgcn_exp2f((bt + cv[e]) * LOG2E) : 0.f; } }
                        ha = MFMA32(tr2(vb + 32 * vstr, vb + 40 * vstr), PACK8(S1, 0), ha);
                        ha = MFMA32(tr2(vb + 48 * vstr, vb + 56 * vstr), PACK8(S1, 8), ha);
                    }
                    const float gw = __builtin_amdgcn_exp2f(bt * LOG2E);
                    LAS float* pk_ = (LAS float*)(lds + ML_PARK + w * 8192) + tt * 1024 + lane;
#pragma unroll
                    for (int e = 0; e < 16; ++e) pk_[e * 64] = gw * hi_[e] + ha[e];
                    if (w == 4 && h == 0) den_t[32 * tt + r] = gw * hi_[0] + ha[0];
                }
                bf16x8 vwf[4];
                { const LAS unsigned char* vb = vwb + (8 * h + (li >> 2)) * vstr + (16 * gg + 4 * (li & 3)) * 2;
#pragma unroll
                  for (int sp = 0; sp < 4; ++sp) vwf[sp] = tr2(vb + (16 * sp) * vstr, vb + (16 * sp + 4) * vstr); }
#pragma unroll
                for (int i = 0; i < 4; ++i) {
#pragma unroll
                    for (int e = 0; e < 16; ++e) C[i][e] *= decay;
                    const LAS unsigned char* kb = lds + ML_KT + (8 * h + (li >> 2)) * KROW + (32 * i + 16 * gg + 4 * (li & 3)) * 2;
#pragma unroll
                    for (int sp = 0; sp < 4; ++sp) C[i] = MFMA32(tr2(kb + (16 * sp) * KROW, kb + (16 * sp + 4) * KROW), vwf[sp], C[i]);
                }
            }
            __syncthreads();
            f32x16 res[2];
            if (w < 4) { const LAS float* pk_ = (const LAS float*)(lds + ML_PARK + w * 8192) + lane;
#pragma unroll
                for (int tt = 0; tt < 2; ++tt)
#pragma unroll
                    for (int e = 0; e < 16; ++e) res[tt][e] = pk_[tt * 1024 + e * 64]; }
            {
                if (w < 4) {
#pragma unroll
                    for (int tt = 0; tt < 2; ++tt) { float* np = num_ptr(NB, r0 + 32 * tt + r, hm) + 32 * w + 4 * h;
#pragma unroll
                        for (int g4 = 0; g4 < 4; ++g4) *(f32x4*)(np + 8 * g4) = (f32x4){res[tt][4 * g4], res[tt][4 * g4 + 1], res[tt][4 * g4 + 2], res[tt][4 * g4 + 3]}; }
                } else if (w == 4) { DEN[(r0 + lane) * 4 + hm] = den_t[lane]; }
                else if (w == 5) { BC[(r0 + lane) * 4 + hm] = Bseg + bsum; }
            }
            Bseg += bL;
        }
        if (w < 5) {
#pragma unroll
            for (int i = 0; i < 4; ++i)
#pragma unroll
                for (int e = 0; e < 16; e += 4) *(f32x4*)(FIMG + ((size_t)(st * 5 + w) * 64 + lane) * 64 + i * 16 + e) = (f32x4){C[i][e], C[i][e + 1], C[i][e + 2], C[i][e + 3]};
        }
        if (tid == 0) DSEG[st] = Bseg;
    }
}
__device__ __forceinline__ void mlstm_pass2(const bf16_t* PR, const bf16_t* QC, const float* gain, bf16_t* Y, LAS unsigned char* lds,
                                            float* NB, const float* DEN, const float* BC, const float* FIMG, const float* DSEG, int st_first, int st_stride) {
    const int tid = tid_here(), lane = tid & 63, w = __builtin_amdgcn_readfirstlane(tid >> 6);
    const int r = lane & 31, h = lane >> 5;
    LAS float* cs_t = (LAS float*)(lds + ML_TAB); LAS float* den_t = cs_t + 64; LAS float* ssq_t = cs_t + 128;
    for (int st = st_first; st < 256; st += st_stride) {
        const int b = st >> 4, hm = (st >> 2) & 3, seg = st & 3;
        __syncthreads();
        bf16x8 sf[4][2];
        if (w < 5) {
            f32x16 S[4];
#pragma unroll
            for (int i = 0; i < 4; ++i)
#pragma unroll
                for (int e = 0; e < 16; ++e) S[i][e] = 0.f;
            for (int j = 0; j < seg; ++j) { const int stj = (st & ~3) + j; const float dj = __expf(DSEG[stj]);
#pragma unroll
                for (int i = 0; i < 4; ++i)
#pragma unroll
                    for (int e = 0; e < 16; e += 4) { const f32x4 fv = *(const f32x4*)(FIMG + ((size_t)(stj * 5 + w) * 64 + lane) * 64 + i * 16 + e);
#pragma unroll
                        for (int k = 0; k < 4; ++k) S[i][e + k] = dj * S[i][e + k] + fv[k]; } }
#pragma unroll
            for (int i = 0; i < 4; ++i) { sf[i][0] = PACK8(S[i], 0); sf[i][1] = PACK8(S[i], 8); }
        }
        const size_t rs0 = (size_t)b * SEQL + 64 * (8 * seg);
        const int frow = tid >> 4, fch = tid & 15;
        const bf16_t* pQ = QC + (rs0 + frow) * 512 + hm * 128 + 8 * fch;
        const int wq = (w < 4) ? w : 0;
        const float* pN = num_ptr(NB, rs0 + r, hm) + 32 * wq + 4 * h;
        const bf16_t* pO = PR + (rs0 + r) * PW + PC_OM + hm * 128 + 32 * wq + 4 * h;
        const float* pB = BC + (rs0 + r) * 4 + hm; const float* pD = DEN + (rs0 + r) * 4 + hm;
        f32x4 gv[4];
#pragma unroll
        for (int g4 = 0; g4 < 4; ++g4) gv[g4] = *(const f32x4*)(gain + hm * 128 + 32 * wq + 8 * g4 + 4 * h);
        u32x4 fQ[2]; f32x4 nv[2][4]; u32x2 ov[2][4]; float bcv[2], dnv[2];
#pragma unroll
        for (int p2 = 0; p2 < 2; ++p2) fQ[p2] = *(const u32x4*)(pQ + (size_t)32 * p2 * 512);
#pragma unroll
        for (int tt = 0; tt < 2; ++tt) { bcv[tt] = pB[tt * 32 * 4]; dnv[tt] = pD[tt * 32 * 4];
#pragma unroll
            for (int g4 = 0; g4 < 4; ++g4) { nv[tt][g4] = *(const f32x4*)(pN + (size_t)tt * 32 * 512 + 8 * g4); ov[tt][g4] = *(const u32x2*)(pO + (size_t)tt * 32 * PW + 8 * g4); } }
        for (int cc = 0; cc < 8; ++cc) {
            const size_t r0 = rs0 + 64 * cc;
#pragma unroll
            for (int p2 = 0; p2 < 2; ++p2) *(LAS u32x4*)(lds + ML_QT + (frow + 32 * p2) * KROW + 16 * fch) = fQ[p2];
            __syncthreads();
            if (cc < 7) { pQ += 64 * 512;
#pragma unroll
                for (int p2 = 0; p2 < 2; ++p2) fQ[p2] = *(const u32x4*)(pQ + (size_t)32 * p2 * 512); }
            f32x16 res[2];
            if (w < 5) {
#pragma unroll
                for (int tt = 0; tt < 2; ++tt) {
                    const LAS unsigned char* qb0 = lds + ML_QT + (32 * tt + r) * KROW + 8 * h;
                    f32x16 acc;
#pragma unroll
                    for (int e = 0; e < 16; ++e) acc[e] = 0.f;
#pragma unroll
                    for (int i = 0; i < 4; ++i)
#pragma unroll
                        for (int s = 0; s < 2; ++s) acc = MFMA32(sf[i][s], lds2x8(qb0 + 64 * i + 32 * s, qb0 + 64 * i + 32 * s + 16), acc);
                    const float gwt = __expf(bcv[tt]);
                    if (w < 4) {
#pragma unroll
                        for (int g4 = 0; g4 < 4; ++g4)
#pragma unroll
                            for (int e = 0; e < 4; ++e) res[tt][4 * g4 + e] = nv[tt][g4][e] + gwt * acc[4 * g4 + e]; }
                    else if (h == 0) den_t[32 * tt + r] = dnv[tt] + gwt * acc[0];
                }
            }
            if (cc < 7) { pN += (size_t)64 * 512; pB += 64 * 4; pD += 64 * 4;
#pragma unroll
                for (int tt = 0; tt < 2; ++tt) { bcv[tt] = pB[tt * 32 * 4]; dnv[tt] = pD[tt * 32 * 4];
#pragma unroll
                    for (int g4 = 0; g4 < 4; ++g4) nv[tt][g4] = *(const f32x4*)(pN + (size_t)tt * 32 * 512 + 8 * g4); } }
            __syncthreads();
            if (w < 4) {
#pragma unroll
                for (int tt = 0; tt < 2; ++tt) {
                    const float dd = 1.f / fmaxf(fabsf(den_t[32 * tt + r]), 1.f); float ss = 0.f;
#pragma unroll
                    for (int g4 = 0; g4 < 4; ++g4) { const u32x2 o2 = ov[tt][g4];
                        const float og[4] = {__uint_as_float(o2.x << 16), __uint_as_float(o2.x & 0xffff0000u), __uint_as_float(o2.y << 16), __uint_as_float(o2.y & 0xffff0000u)};
#pragma unroll
                        for (int e = 0; e < 4; ++e) { const float v = res[tt][4 * g4 + e] * dd * sigmoid_f(og[e]); res[tt][4 * g4 + e] = v; ss += v * v; } }
                    ss += __shfl_xor(ss, 32);
                    if (h == 0) ssq_t[64 * w + 32 * tt + r] = ss;
                }
            }
            if (cc < 7) { pO += (size_t)64 * PW;
#pragma unroll
                for (int tt = 0; tt < 2; ++tt)
#pragma unroll
                    for (int g4 = 0; g4 < 4; ++g4) ov[tt][g4] = *(const u32x2*)(pO + (size_t)tt * 32 * PW + 8 * g4); }
            __syncthreads();
            if (w < 4) {
#pragma unroll
                for (int tt = 0; tt < 2; ++tt) {
                    const int t = 32 * tt + r;
                    const float rr = rsqrtf(((ssq_t[t] + ssq_t[64 + t]) + (ssq_t[128 + t] + ssq_t[192 + t])) * (1.f / 128.f) + EPS);
#pragma unroll
                    for (int g4 = 0; g4 < 4; ++g4) { const int d0 = hm * 128 + 32 * w + 8 * g4 + 4 * h;
                        u32x2 o; o.x = pk2(res[tt][4 * g4] * rr * gv[g4][0], res[tt][4 * g4 + 1] * rr * gv[g4][1]); o.y = pk2(res[tt][4 * g4 + 2] * rr * gv[g4][2], res[tt][4 * g4 + 3] * rr * gv[g4][3]);
                        *(u32x2*)(Y + (r0 + t) * DM + 512 + d0) = o; }
                }
            }
        }
    }
}

__global__ void __launch_bounds__(512, 2) mega(Args a) {
    extern __shared__ __attribute__((aligned(16))) unsigned char lds_raw[];
    LAS unsigned char* lds = (LAS unsigned char*)lds_raw;
    cg::grid_group grid = cg::this_grid();
    unsigned char* ws = a.ws;
    bf16_t* XN = (bf16_t*)(ws + WS_XN); bf16_t* HB = (bf16_t*)(ws + WS_H); bf16_t* PR = (bf16_t*)(ws + WS_H); bf16_t* Y = (bf16_t*)a.out; bf16_t* XN3 = (bf16_t*)(ws + WS_XN3);
    float* SS2 = (float*)(ws + WS_SS2); float* SS3 = (float*)(ws + WS_SS3); float* GT = (float*)(ws + WS_G);
    const int G = gridDim.x, bx = blockIdx.x;
    volatile LAS unsigned* MISC = (volatile LAS unsigned*)(lds + 131072 + 320);
    if (threadIdx.x < 32) MISC[threadIdx.x] = 0u;
    __syncthreads();
    if (a.ws == nullptr) grid.sync();
    const XcdBarrier bar = xcd_barrier_post((unsigned*)(ws + WS_BAR), MISC + 8);
    prologue(a, lds);
    xcd_barrier(bar);
#if PROBE_DUP & 1
    prologue(a, lds);
    xcd_barrier(bar);
#endif
#if PROBE_DUP & 32
    for (int i = 0; i < 8; ++i) xcd_barrier(bar);
#endif
    { pg8::Gemm g{XN, (const bf16_t*)(ws + WS_WG1), MTOK, NGU, 1024}; pg8::StaticOrder S; S.init(MTOK, NGU, G, bx); EpiSwiGLU E{HB, nullptr};
      pg8::gemm_phase<EpiSwiGLU, pg8::StaticOrder, true, true>(lds, g, S, E); }
    xcd_barrier(bar);
    { pg8::Gemm g{HB, (const bf16_t*)(ws + WS_WD1), MTOK, DM, DFF}; pg8::StaticOrder S; S.init(MTOK, DM, G, bx); EpiResG<false, true> E{a.in[I_X], XN, 0.5f, SS2};
      pg8::gemm_phase<EpiResG<false, true>, pg8::StaticOrder, true, true>(lds, g, S, E); }
    xcd_barrier(bar);
    { pg8::Gemm g{XN, (const bf16_t*)(ws + WS_WIN), MTOK, PW, 1024}; pg8::StaticOrder S; S.init(MTOK, PW, G, bx); EpiProj E{PR, GT, SS2, a.in[I_QNW], a.in[I_KNW], a.in[I_IB], a.in[I_FB]};
      pg8::gemm_phase<EpiProj, pg8::StaticOrder, true, true>(lds, g, S, E);
      gates_job(XN, (const bf16_t*)(ws + WS_WIN), SS2, a.in[I_IB], a.in[I_FB], GT, lds); }
    xcd_barrier(bar);
#define WSP(T, off) ((T*)(wsl + (off)))
#define NUMB ((float*)a.out + (size_t)16 * 1024 * 1024)
    {
        unsigned char* wsl = ws; asm volatile("" : "+s"(wsl));
        for (int st = bx; st < 256; st += G) {
            conv_local(WSP(bf16_t, WS_H), a.in[I_CW], a.in[I_CB], WSP(bf16_t, WS_QC), WSP(bf16_t, WS_KC), st);
            __syncthreads();
            mlstm_pass1(WSP(bf16_t, WS_H), WSP(bf16_t, WS_QC), WSP(bf16_t, WS_KC), WSP(float, WS_G), a.in[I_MG], (bf16_t*)a.out, lds, NUMB, WSP(float, WS_DEN), WSP(float, WS_BC), WSP(float, WS_FIMG), WSP(float, WS_DSEG), st, 256);
            __syncthreads();
        }
    }
    {
        unsigned char* wsl = ws; asm volatile("" : "+s"(wsl));
        const int tid4 = tid_here(); const int lane = tid4 & 63, wave = __builtin_amdgcn_readfirstlane(tid4 >> 6);
        LAS unsigned char* vl = lds + wave * 9216;
        for (int task = bx * 8 + wave; task < 16384; task += G * 8) {
            const int br = task >> 13, tk = task & 8191, bh = tk >> 6, wq = tk & 63;
            attn_task<0>(WSP(bf16_t, WS_H), bh >> 3, bh & 7, br ? (wq >> 2) : (wq >> 4), br ? 16 : 4, br ? (wq & 3) : (wq & 15), vl, br ? WSP(bf16_t, WS_P16) : WSP(bf16_t, WS_P4), br ? WSP(float, WS_L16) : WSP(float, WS_L4),
                         nullptr, nullptr, nullptr, nullptr, nullptr, nullptr, lane);
        }
    }
    xcd_barrier(bar);
    {
        unsigned char* wsl = ws; asm volatile("" : "+s"(wsl));
        mlstm_pass2(WSP(bf16_t, WS_H), WSP(bf16_t, WS_QC), a.in[I_MG], (bf16_t*)a.out, lds, NUMB, WSP(float, WS_DEN), WSP(float, WS_BC), WSP(float, WS_FIMG), WSP(float, WS_DSEG), bx, G);
        __syncthreads();
    }
    {
        unsigned char* wsl = ws; asm volatile("" : "+s"(wsl));
        const int tid4 = tid_here(); const int lane = tid4 & 63, wave = __builtin_amdgcn_readfirstlane(tid4 >> 6);
        LAS unsigned char* vl = lds + wave * 9216;
        for (int task = bx * 8 + wave; task < 8192; task += G * 8) { const int bh = task >> 6, wq = task & 63;
            attn_task<1>(WSP(bf16_t, WS_H), bh >> 3, bh & 7, 0, 1, wq, vl, nullptr, nullptr, WSP(bf16_t, WS_P4), WSP(bf16_t, WS_P16), WSP(float, WS_L4), WSP(float, WS_L16), a.in[I_AG], (bf16_t*)a.out, lane); }
    }
#undef NUMB
#undef WSP
    xcd_barrier(bar);
    { pg8::Gemm g{Y, (const bf16_t*)(ws + WS_WOUT), MTOK, DM, 1024}; pg8::StaticOrder S; S.init(MTOK, DM, G, bx); EpiResG<true, true> E{XN, XN3, 1.0f, SS3};
      pg8::gemm_phase<EpiResG<true, true>, pg8::StaticOrder, true, true>(lds, g, S, E); }
    xcd_barrier(bar);
    { pg8::Gemm g{XN3, (const bf16_t*)(ws + WS_WG2), MTOK, NGU, 1024}; pg8::StaticOrder S; S.init(MTOK, NGU, G, bx); EpiSwiGLU E{HB, SS3};
      pg8::gemm_phase<EpiSwiGLU, pg8::StaticOrder, true, true>(lds, g, S, E); }
    xcd_barrier(bar);
    { pg8::Gemm g{HB, (const bf16_t*)(ws + WS_WD2), MTOK, DM, DFF}; pg8::StaticOrder S; S.init(MTOK, DM, G, bx); EpiResG<true, false> E{XN3, a.out, 0.5f, nullptr};
      pg8::gemm_phase<EpiResG<true, false>, pg8::StaticOrder, true, true>(lds, g, S, E); }
}

extern "C" void kernel_launch(void* const* d_in, const int* in_sizes, int n_in, void* d_out, int out_size, void* d_ws, size_t ws_size, hipStream_t stream) {
    static int grid = 0;
    if (grid == 0) {
        int dev = 0, cus = 0, per_cu = 0;
        (void)hipGetDevice(&dev); (void)hipDeviceGetAttribute(&cus, hipDeviceAttributeMultiprocessorCount, dev);
        if (hipFuncSetAttribute((const void*)mega, hipFuncAttributeMaxDynamicSharedMemorySize, LDS_BYTES) != hipSuccess) fprintf(stderr, "kernel_launch: hipFuncSetAttribute failed\n");
        if (hipOccupancyMaxActiveBlocksPerMultiprocessor(&per_cu, (const void*)mega, 512, LDS_BYTES) != hipSuccess || per_cu < 1) fprintf(stderr, "kernel_launch: occupancy query says %d\n", per_cu);
        (void)hipGetLastError();
        if (cus <= 0) cus = 256;
        grid = cus;
        if (n_in != 20 || ws_size < WS_END) fprintf(stderr, "kernel_launch: unexpected n_in %d / ws %zu\n", n_in, ws_size);
    }
    Args a{};
    for (int i = 0; i < 20; ++i) a.in[i] = (const float*)d_in[i];
    a.out = (float*)d_out; a.ws = (unsigned char*)d_ws;
    if (hipMemsetAsync((char*)d_ws + WS_BAR, 0, 16384, stream) != hipSuccess) fprintf(stderr, "kernel_launch: memset of the barrier words failed\n");
    void* args[] = {&a};
    hipError_t e = hipLaunchCooperativeKernel((const void*)mega, dim3(grid), dim3(512), args, LDS_BYTES, stream);
    if (e != hipSuccess) fprintf(stderr, "kernel_launch: cooperative launch failed: %s (grid %d)\n", hipGetErrorString(e), grid);
}
```
